# Optimizing an MI355X kernel written in HIP

```python
import math
import jax, jax.numpy as jnp
from jax import lax
import numpy as np

D_MODEL = 1024
BATCH = 4
SEQ = 4096
DEPTH = 2

N_A = DEPTH // 2
N_B = DEPTH - N_A
CONV_W = 3
HEAD_DIM = 64
N_HEADS = D_MODEL // HEAD_DIM
N_KV_HEADS = 4
GROUP = N_HEADS // N_KV_HEADS
WINDOW = 128
BLOCK = 128
ROT_DIM = HEAD_DIM // 4
ROPE_THETA = 500000.0
D_FF = ((8 * D_MODEL // 3 + 255) // 256) * 256
EPS = 1e-6
NEG = -1e30

kernel_name = "yoco_shortconv_swa_sink_hybrid"


def rmsnorm(x, g):
    xf = x.astype(jnp.float32)
    r = lax.rsqrt(jnp.mean(xf * xf, axis=-1, keepdims=True) + EPS)
    return (xf * r).astype(x.dtype) * g


def rope_tables(seq_len, dtype):
    inv_freq = ROPE_THETA ** (-jnp.arange(0, ROT_DIM, 2, dtype=jnp.float32) / ROT_DIM)
    ang = jnp.arange(seq_len, dtype=jnp.float32)[:, None] * inv_freq[None, :]
    return jnp.cos(ang)[:, None, :].astype(dtype), jnp.sin(ang)[:, None, :].astype(dtype)


def partial_rotary(t, cos, sin):
    half = ROT_DIM // 2
    t1, t2, rest = t[..., :half], t[..., half:ROT_DIM], t[..., ROT_DIM:]
    return jnp.concatenate([t1 * cos - t2 * sin, t2 * cos + t1 * sin, rest], axis=-1)


def causal_depthwise_conv3(u, w):
    s = u.shape[1]
    up = jnp.pad(u, ((0, 0), (CONV_W - 1, 0), (0, 0)))
    return up[:, 0:s] * w[0] + up[:, 1:s + 1] * w[1] + up[:, 2:s + 2] * w[2]


def short_conv_mixer(h, w_in, conv_w, w_out):
    bcx = h @ w_in
    b_gate, c_gate, u = jnp.split(bcx, 3, axis=-1)
    y = b_gate * causal_depthwise_conv3(c_gate * u, conv_w)
    return y @ w_out


def swiglu(h, w_gate_up, w_down):
    g, u = jnp.split(h @ w_gate_up, 2, axis=-1)
    return (jax.nn.silu(g) * u) @ w_down


def sliding_window_sink_attention(q, k, v, sinks):
    bsz, s = q.shape[0], q.shape[1]
    nb = s // BLOCK
    qb = q.reshape(bsz, nb, BLOCK, N_KV_HEADS, GROUP, HEAD_DIM)

    def with_prev(t):
        tb = t.reshape(bsz, nb, BLOCK, N_KV_HEADS, HEAD_DIM)
        prev = jnp.concatenate([jnp.zeros_like(tb[:, :1]), tb[:, :-1]], axis=1)
        return jnp.concatenate([prev, tb], axis=2)

    kk, vv = with_prev(k), with_prev(v)
    scale = 1.0 / math.sqrt(HEAD_DIM)
    scores = jnp.einsum('bnqhgd,bnkhd->bnhgqk', qb, kk).astype(jnp.float32) * scale

    qi = jnp.arange(BLOCK)[:, None]
    kj = jnp.arange(2 * BLOCK)[None, :]
    diff = BLOCK + qi - kj
    band = (diff >= 0) & (diff < WINDOW)
    not_pad = (jnp.arange(nb)[:, None, None] > 0) | (kj[None] >= BLOCK)
    valid = band[None] & not_pad
    scores = jnp.where(valid[None, :, None, None], scores, NEG)

    sink = jnp.broadcast_to(
        sinks.astype(jnp.float32).reshape(N_KV_HEADS, GROUP)[None, None, :, :, None, None],
        scores.shape[:-1] + (1,))
    probs = jax.nn.softmax(jnp.concatenate([scores, sink], axis=-1), axis=-1)[..., :-1]
    out = jnp.einsum('bnhgqk,bnkhd->bnqhgd', probs.astype(v.dtype), vv)
    return out.reshape(bsz, s, N_HEADS * HEAD_DIM)


def setup_inputs(seed: int = 0) -> dict:
    key = jax.random.key(seed)
    ks = jax.random.split(key, 24)
    f32 = jnp.float32
    D, F = D_MODEL, D_FF
    QD = N_HEADS * HEAD_DIM
    KVD = N_KV_HEADS * HEAD_DIM

    def nrm(k, shape, fan_in):
        return jax.random.normal(k, shape, f32) * (fan_in ** -0.5)

    def gain(k, shape):
        return 1.0 + 0.05 * jax.random.normal(k, shape, f32)

    return {
        "x": jax.random.normal(ks[0], (BATCH, SEQ, D), f32),
        "a_pre_norm": gain(ks[1], (N_A, D)),
        "a_w_in": nrm(ks[2], (N_A, D, 3 * D), D),
        "a_conv_w": nrm(ks[3], (N_A, CONV_W, D), CONV_W),
        "a_w_out": nrm(ks[4], (N_A, D, D), D),
        "a_post_norm": gain(ks[5], (N_A, D)),
        "ffn_pre_norm": gain(ks[6], (DEPTH, D)),
        "ffn_w_gate_up": nrm(ks[7], (DEPTH, D, 2 * F), D),
        "ffn_w_down": nrm(ks[8], (DEPTH, F, D), F),
        "ffn_post_norm": gain(ks[9], (DEPTH, D)),
        "kv_norm": gain(ks[10], (D,)),
        "w_kv": nrm(ks[11], (D, 2 * KVD), D),
        "b_pre_norm": gain(ks[12], (N_B, D)),
        "b_w_q": nrm(ks[13], (N_B, D, QD), D),
        "b_sinks": 0.5 * jax.random.normal(ks[14], (N_B, N_HEADS), f32),
        "b_w_o": nrm(ks[15], (N_B, QD, D), QD),
        "b_post_norm": gain(ks[16], (N_B, D)),
    }


def reference(x, a_pre_norm, a_w_in, a_conv_w, a_w_out, a_post_norm,
              ffn_pre_norm, ffn_w_gate_up, ffn_w_down, ffn_post_norm,
              kv_norm, w_kv,
              b_pre_norm, b_w_q, b_sinks, b_w_o, b_post_norm):
    bsz, s, _ = x.shape
    cos, sin = rope_tables(s, x.dtype)
    h = x
    for l in range(DEPTH):
        if l < N_A:
            mix = short_conv_mixer(rmsnorm(h, a_pre_norm[l]), a_w_in[l], a_conv_w[l], a_w_out[l])
            h = h + rmsnorm(mix, a_post_norm[l])
        else:
            j = l - N_A
            if j == 0:
                kv = rmsnorm(h, kv_norm) @ w_kv
                k_sh, v_sh = jnp.split(kv, 2, axis=-1)
                k_sh = partial_rotary(k_sh.reshape(bsz, s, N_KV_HEADS, HEAD_DIM), cos, sin)
                v_sh = v_sh.reshape(bsz, s, N_KV_HEADS, HEAD_DIM)
            q = (rmsnorm(h, b_pre_norm[j]) @ b_w_q[j]).reshape(bsz, s, N_HEADS, HEAD_DIM)
            q = partial_rotary(q, cos, sin)
            attn = sliding_window_sink_attention(q, k_sh, v_sh, b_sinks[j]) @ b_w_o[j]
            h = h + rmsnorm(attn, b_post_norm[j])
        ff = swiglu(rmsnorm(h, ffn_pre_norm[l]), ffn_w_gate_up[l], ffn_w_down[l])
        h = h + rmsnorm(ff, ffn_post_norm[l])
    return h
```

```cpp
#include <cstring>
#include <hip/hip_runtime.h>
#include <cstdio>
#include <cstdint>
namespace pg8 {
#define PG8_LAS __attribute__((address_space(3)))
typedef unsigned short bf16_t;
typedef short bf16x8 __attribute__((ext_vector_type(8)));
typedef float f32x4 __attribute__((ext_vector_type(4)));
typedef unsigned u32x4 __attribute__((ext_vector_type(4)));
constexpr int BM = 256, BK = 64, HALF = 128, HTB = HALF * BK * 2  , STAGE_BYTES = 8 * HTB, NXCD = 8, WGM = 8;

__host__ __device__ __forceinline__ int lds_byte(int r, int c) { const int st = (r >> 4) * 2 + (c >> 5), rr = r & 15, cc = c & 31, ob = rr * 64 + cc * 2; return st * 1024 + (ob ^ (((ob >> 9) & 1) << 5)); }
__host__ __device__ __forceinline__ void stage_rc(int b, int& R, int& C) { const int st = b / 1024, sb = b % 1024, swz = sb ^ (((sb >> 9) & 1) << 5); R = (st >> 1) * 16 + swz / 64; C = (st & 1) * 32 + (swz % 64) / 2; }
__host__ __device__ __forceinline__ int perm32(int rho) { const int n = rho >> 4, i = rho & 15; return 8 * (i >> 2) + 4 * n + (i & 3); }

struct Unit { int pm, pn; };
struct Gemm { const bf16_t* A; const bf16_t* Bt; int M, N, K; };

struct StaticOrder {
    int nM, nN, nwg, G, c;
    __host__ __device__ void init(int M, int N, int G_, int c_) { nM = M / BM; nN = N / BM; nwg = nM * nN; G = G_; c = c_; }
    __host__ __device__ bool next(int i, Unit& u) const {
        const long L = (long)i * G + c; if (L >= nwg) return false;
        int wgid = (int)L; { const int q = nwg / NXCD, r = nwg % NXCD, xcd = wgid % NXCD, off = wgid / NXCD; wgid = (xcd < r ? xcd * (q + 1) : r * (q + 1) + (xcd - r) * q) + off; }
        const int nig = WGM * nN, gid = wgid / nig, fm = gid * WGM, gsz = (nM - fm) < WGM ? (nM - fm) : WGM;
        u.pm = fm + ((wgid % nig) % gsz); u.pn = (wgid % nig) / gsz; return true;
    }
    __device__ __forceinline__ void a_ready(const Unit&) const {}
    __device__ __forceinline__ void done(const Unit&) const {}
};

__device__ __forceinline__ unsigned cvt_pk_bf16(float lo, float hi) { unsigned r; asm volatile("v_cvt_pk_bf16_f32 %0, %1, %2" : "=v"(r) : "v"(lo), "v"(hi)); return r; }
typedef float f32x2 __attribute__((ext_vector_type(2)));
__device__ __forceinline__ f32x2 gelu_pk(f32x2 v) {
    const f32x2 av = __builtin_elementwise_abs(v), d = av * 0.2316418882f + 1.0f;
    f32x2 t; t.x = __builtin_amdgcn_rcpf(d.x); t.y = __builtin_amdgcn_rcpf(d.y);
    f32x2 q = t * 0.5307027145f + (-0.7265760135f); q = q * t + 0.7107068705f; q = q * t + (-0.142248368f); q = q * t + 0.127414796f; q = q * t;
    const f32x2 s = (v * v) * (-0.72134752044f);
    f32x2 e; e.x = __builtin_amdgcn_exp2f(s.x); e.y = __builtin_amdgcn_exp2f(s.y);
    const f32x2 m = v * (q * e), r = v - m;
    f32x2 o; o.x = v.x < 0.f ? m.x : r.x; o.y = v.y < 0.f ? m.y : r.y; return o;
}

template <int ACT  > struct EpiBf16 {
    static constexpr bool PERM = true, AFTER_DRAIN = false; static_assert(ACT == 0 || ACT == 1, "EpiBf16: ACT is 0 (none) or 1 (gelu_pk)");
    bf16_t* O; int ldc; const float* bias; int split_cols; size_t split_stride; float scale0;
    __device__ __forceinline__ void operator()(const f32x4 (&acc)[2][2][4][2], const Unit& u, int wr, int wc, int fr, int fq) const {
        const int row0 = u.pm * BM + wr * 64 + fr; int colt = u.pn * BM; bf16_t* base = O;
        float sc = 1.f; if (split_cols) { const int t = colt / split_cols; base += (size_t)t * split_stride; colt -= t * split_cols; if (t == 0) sc = scale0; }
        const int col0 = colt + wc * 32 + 8 * fq, bcol0 = u.pn * BM + wc * 32 + 8 * fq;
        f32x4 bv[2][2];
#pragma unroll
        for (int bj = 0; bj < 2; ++bj)
#pragma unroll
            for (int n = 0; n < 2; ++n) bv[bj][n] = bias ? *(const f32x4*)(bias + bcol0 + bj * HALF + 4 * n) : (f32x4){0.f, 0.f, 0.f, 0.f};
#pragma unroll
        for (int ai = 0; ai < 2; ++ai)
#pragma unroll
            for (int m = 0; m < 4; ++m) { bf16_t* rowp = base + (size_t)(row0 + ai * HALF + m * 16) * ldc + col0;
#pragma unroll
                for (int bj = 0; bj < 2; ++bj) { f32x4 v0 = acc[ai][bj][m][0] + bv[bj][0], v1 = acc[ai][bj][m][1] + bv[bj][1];
                    if (ACT == 1) { f32x2 a = gelu_pk((f32x2){v0[0], v0[1]}), b = gelu_pk((f32x2){v0[2], v0[3]}), c = gelu_pk((f32x2){v1[0], v1[1]}), d = gelu_pk((f32x2){v1[2], v1[3]});
                        v0 = (f32x4){a.x, a.y, b.x, b.y}; v1 = (f32x4){c.x, c.y, d.x, d.y}; }
                    v0 = v0 * sc; v1 = v1 * sc; u32x4 w; w.x = cvt_pk_bf16(v0[0], v0[1]); w.y = cvt_pk_bf16(v0[2], v0[3]); w.z = cvt_pk_bf16(v1[0], v1[1]); w.w = cvt_pk_bf16(v1[2], v1[3]);
                    *(u32x4*)(rowp + bj * HALF) = w; } }
    }
};
struct EpiF32 {
    static constexpr bool PERM = false, AFTER_DRAIN = false;
    float* C; int ldc;
    __device__ __forceinline__ void operator()(const f32x4 (&acc)[2][2][4][2], const Unit& u, int wr, int wc, int fr, int fq) const {
        const int row0 = u.pm * BM + wr * 64 + fr, col0 = u.pn * BM + wc * 32 + 4 * fq;
#pragma unroll
        for (int ai = 0; ai < 2; ++ai)
#pragma unroll
            for (int m = 0; m < 4; ++m) { float* rowp = C + (size_t)(row0 + ai * HALF + m * 16) * ldc + col0;
#pragma unroll
                for (int bj = 0; bj < 2; ++bj)
#pragma unroll
                    for (int n = 0; n < 2; ++n) *(f32x4*)(rowp + bj * HALF + n * 16) = acc[ai][bj][m][n]; }
    }
};
__device__ __forceinline__ float silu_mul(float g, float u) { return g * u * __builtin_amdgcn_rcpf(1.0f + __builtin_amdgcn_exp2f(-1.4426950408889634f * g)); }
struct EpiSwiGLU {
    static constexpr bool PERM = true, AFTER_DRAIN = false;
    bf16_t* O; int ldc;
    __device__ __forceinline__ void operator()(const f32x4 (&acc)[2][2][4][2], const Unit& u, int wr, int wc, int fr, int fq) const {
        const int row0 = u.pm * BM + wr * 64 + fr, col0 = u.pn * HALF + wc * 32 + 8 * fq;
#pragma unroll
        for (int ai = 0; ai < 2; ++ai)
#pragma unroll
            for (int m = 0; m < 4; ++m) { bf16_t* rowp = O + (size_t)(row0 + ai * HALF + m * 16) * ldc + col0;
                const f32x4 g0 = acc[ai][0][m][0], g1 = acc[ai][0][m][1], u0 = acc[ai][1][m][0], u1 = acc[ai][1][m][1];
                u32x4 w; w.x = cvt_pk_bf16(silu_mul(g0[0], u0[0]), silu_mul(g0[1], u0[1])); w.y = cvt_pk_bf16(silu_mul(g0[2], u0[2]), silu_mul(g0[3], u0[3]));
                w.z = cvt_pk_bf16(silu_mul(g1[0], u1[0]), silu_mul(g1[1], u1[1])); w.w = cvt_pk_bf16(silu_mul(g1[2], u1[2]), silu_mul(g1[3], u1[3]));
                *(u32x4*)rowp = w; }
    }
};
template <class Epi, class Sched, bool ALIGN_EPI = false, bool SP2 = false>
__device__ __forceinline__ void gemm_phase(PG8_LAS unsigned char* lds, const Gemm g, const Sched& S, const Epi& E) {
    const int tid = threadIdx.x, wid = __builtin_amdgcn_readfirstlane(tid >> 6), lane = tid & 63, wr = wid >> 2, wc = wid & 3, fr = lane & 15, fq = lane >> 4;
    const int K = g.K, nt = K / BK;
    unsigned voffA[2], voffB[2];
#pragma unroll
    for (int i = 0; i < 2; ++i) { int R, C; stage_rc(tid * 16 + i * 8192, R, C); const int Rb = Epi::PERM ? ((R & ~31) + perm32(R & 31)) : R;
        voffA[i] = (unsigned)(R * K + C) * 2u; voffB[i] = (unsigned)(Rb * K + C) * 2u; }
    const size_t kstep = (size_t)(BK * 2);
    const size_t hstep = (size_t)HALF * K * 2;
    const size_t tstep = 2 * hstep;
    const unsigned ldsw = (unsigned)wid * 1024u;
    const int aoff = lds_byte(wr * 64 + fr, fq * 8), boff = lds_byte(wc * 32 + fr, fq * 8);
#define PG8_SA(b, h) (((b) * 2 + (h)) * HTB)
#define PG8_SB(b, h) ((4 + (b) * 2 + (h)) * HTB)
#define PG8_STAGE(bufoff, gbase, voff) do { _Pragma("unroll") for (int _i = 0; _i < 2; ++_i) \
        __builtin_amdgcn_global_load_lds((const unsigned*)((const char*)(gbase) + (voff)[_i]), (PG8_LAS unsigned*)(lds + (bufoff) + ldsw + _i * 8192), 16, 0, 0); } while (0)
#define PG8_LDA(dst, b, h) do { _Pragma("unroll") for (int m = 0; m < 4; ++m) _Pragma("unroll") for (int k = 0; k < 2; ++k) dst[m][k] = *(const PG8_LAS bf16x8*)(lds + PG8_SA(b, h) + aoff + m * 2048 + k * 1024); } while (0)
#define PG8_LDB(dst, b, h) do { _Pragma("unroll") for (int n = 0; n < 2; ++n) _Pragma("unroll") for (int k = 0; k < 2; ++k) dst[n][k] = *(const PG8_LAS bf16x8*)(lds + PG8_SB(b, h) + boff + n * 2048 + k * 1024); } while (0)
#define PG8_MMA(ai, bj, At, Bt) do { __builtin_amdgcn_s_setprio(1); _Pragma("unroll") for (int m = 0; m < 4; ++m) _Pragma("unroll") for (int n = 0; n < 2; ++n) _Pragma("unroll") for (int k = 0; k < 2; ++k) \
        acc[ai][bj][m][n] = __builtin_amdgcn_mfma_f32_16x16x32_bf16(Bt[n][k], At[m][k], acc[ai][bj][m][n], 0, 0, 0); __builtin_amdgcn_s_setprio(0); } while (0)
#define PG8_WAIT_V(n) asm volatile("s_waitcnt vmcnt(" #n ")" ::: "memory")
#define PG8_WAIT_L(n) asm volatile("s_waitcnt lgkmcnt(" #n ")" ::: "memory")
#define PG8_BAR __builtin_amdgcn_s_barrier()
#define PG8_SCHED __builtin_amdgcn_sched_barrier(0)
    Unit cur, nxt; int ui = 0;
    if (!S.next(0, cur)) return;
    f32x4 acc[2][2][4][2];
#pragma unroll
    for (int a = 0; a < 2; ++a)
#pragma unroll
        for (int b = 0; b < 2; ++b)
#pragma unroll
            for (int m = 0; m < 4; ++m)
#pragma unroll
                for (int n = 0; n < 2; ++n) acc[a][b][m][n] = (f32x4){0.f, 0.f, 0.f, 0.f};
    bf16x8 At[4][2], B0[2][2], B1[2][2];
    const char* cA = (const char*)g.A + (size_t)cur.pm * tstep; const char* cB = (const char*)g.Bt + (size_t)cur.pn * tstep;
    S.a_ready(cur);
    if constexpr (SP2) {
        PG8_STAGE(PG8_SB(0, 0), cB, voffB); PG8_STAGE(PG8_SB(0, 1), cB + hstep, voffB); PG8_STAGE(PG8_SA(0, 0), cA, voffA); PG8_STAGE(PG8_SA(0, 1), cA + hstep, voffA);
        if (wr == 1) PG8_BAR;
        PG8_WAIT_V(2); PG8_BAR;
        PG8_STAGE(PG8_SB(1, 0), cB + kstep, voffB); PG8_STAGE(PG8_SA(1, 0), cA + kstep, voffA); PG8_STAGE(PG8_SB(1, 1), cB + hstep + kstep, voffB);
        PG8_WAIT_V(6); PG8_BAR;
    } else {
        PG8_STAGE(PG8_SB(0, 0), cB, voffB); PG8_STAGE(PG8_SA(0, 0), cA, voffA); PG8_STAGE(PG8_SB(0, 1), cB + hstep, voffB); PG8_STAGE(PG8_SA(0, 1), cA + hstep, voffA);
        if (wr == 1) PG8_BAR;
        PG8_WAIT_V(4); PG8_BAR;
        PG8_STAGE(PG8_SB(1, 0), cB + kstep, voffB); PG8_STAGE(PG8_SA(1, 0), cA + kstep, voffA); PG8_STAGE(PG8_SB(1, 1), cB + hstep + kstep, voffB);
        PG8_WAIT_V(6); PG8_BAR;
    }
    for (;;) {
        const bool has_next = S.next(ui + 1, nxt);
        const char* nA = has_next ? (const char*)g.A + (size_t)nxt.pm * tstep : cA; const char* nB = has_next ? (const char*)g.Bt + (size_t)nxt.pn * tstep : cB;
        for (int t = 0; t < nt; t += 2) {
            const bool last = (t == nt - 2);
            const char* a1 = cA + (size_t)(t + 1) * kstep;
            const char* a2 = last ? nA : cA + (size_t)(t + 2) * kstep; const char* b2 = last ? nB : cB + (size_t)(t + 2) * kstep;
            const char* a3 = a2 + kstep; const char* b3 = b2 + kstep;
            if (last && has_next) S.a_ready(nxt);
            if constexpr (SP2) {
            PG8_LDB(B0, 0, 0); PG8_LDB(B1, 0, 1); PG8_SCHED; PG8_LDA(At, 0, 0); PG8_STAGE(PG8_SA(1, 1), a1 + hstep, voffA);
            PG8_WAIT_V(8); PG8_WAIT_L(0); PG8_BAR; PG8_MMA(0, 0, At, B0); PG8_MMA(0, 1, At, B1); PG8_BAR; PG8_SCHED;
            PG8_LDA(At, 0, 1); PG8_STAGE(PG8_SB(0, 0), b2, voffB); PG8_STAGE(PG8_SB(0, 1), b2 + hstep, voffB); PG8_STAGE(PG8_SA(0, 0), a2, voffA);
            PG8_WAIT_V(8); PG8_WAIT_L(0); PG8_BAR; PG8_MMA(1, 0, At, B0); PG8_MMA(1, 1, At, B1); PG8_BAR; PG8_SCHED;
            PG8_LDB(B0, 1, 0); PG8_LDB(B1, 1, 1); PG8_SCHED; PG8_LDA(At, 1, 0); PG8_STAGE(PG8_SA(0, 1), a2 + hstep, voffA);
            PG8_WAIT_V(8); PG8_WAIT_L(0); PG8_BAR; PG8_MMA(0, 0, At, B0); PG8_MMA(0, 1, At, B1); PG8_BAR; PG8_SCHED;
            PG8_LDA(At, 1, 1); PG8_STAGE(PG8_SB(1, 0), b3, voffB); PG8_STAGE(PG8_SB(1, 1), b3 + hstep, voffB); PG8_STAGE(PG8_SA(1, 0), a3, voffA);
            PG8_WAIT_V(8); PG8_WAIT_L(0); PG8_BAR; PG8_MMA(1, 0, At, B0); PG8_MMA(1, 1, At, B1); PG8_BAR; PG8_SCHED;
            } else {
            PG8_LDB(B0, 0, 0); PG8_SCHED; PG8_LDA(At, 0, 0); PG8_STAGE(PG8_SA(1, 1), a1 + hstep, voffA);
            PG8_WAIT_L(8); PG8_BAR; PG8_WAIT_L(0); PG8_MMA(0, 0, At, B0); PG8_BAR; PG8_SCHED;
            PG8_LDB(B1, 0, 1); PG8_STAGE(PG8_SB(0, 0), b2, voffB);
            PG8_BAR; PG8_WAIT_L(0); PG8_MMA(0, 1, At, B1); PG8_BAR;
            PG8_LDA(At, 0, 1); PG8_STAGE(PG8_SA(0, 0), a2, voffA);
            PG8_BAR; PG8_WAIT_L(0); PG8_MMA(1, 0, At, B0); PG8_BAR; PG8_SCHED;
            PG8_STAGE(PG8_SB(0, 1), b2 + hstep, voffB);
            PG8_WAIT_V(6); PG8_BAR; PG8_MMA(1, 1, At, B1); PG8_BAR;
            PG8_LDB(B0, 1, 0); PG8_SCHED; PG8_LDA(At, 1, 0); PG8_STAGE(PG8_SA(0, 1), a2 + hstep, voffA);
            PG8_WAIT_L(8); PG8_BAR; PG8_WAIT_L(0); PG8_MMA(0, 0, At, B0); PG8_BAR; PG8_SCHED;
            PG8_LDB(B1, 1, 1); PG8_STAGE(PG8_SB(1, 0), b3, voffB);
            PG8_BAR; PG8_WAIT_L(0); PG8_MMA(0, 1, At, B1); PG8_BAR;
            PG8_LDA(At, 1, 1); PG8_STAGE(PG8_SA(1, 0), a3, voffA);
            PG8_BAR; PG8_WAIT_L(0); PG8_MMA(1, 0, At, B0); PG8_BAR; PG8_SCHED;
            PG8_STAGE(PG8_SB(1, 1), b3 + hstep, voffB);
            PG8_WAIT_V(6); PG8_BAR; PG8_MMA(1, 1, At, B1); PG8_BAR;
            }
        }
        if constexpr (ALIGN_EPI) { if (wr == 0) PG8_BAR; }
        if constexpr (!Epi::AFTER_DRAIN) { E(acc, cur, wr, wc, fr, fq); S.done(cur); }
        if (!has_next) break;
#pragma unroll
        for (int a = 0; a < 2; ++a)
#pragma unroll
            for (int b = 0; b < 2; ++b)
#pragma unroll
                for (int m = 0; m < 4; ++m)
#pragma unroll
                    for (int n = 0; n < 2; ++n) acc[a][b][m][n] = (f32x4){0.f, 0.f, 0.f, 0.f};
        cur = nxt; cA = nA; cB = nB; ++ui;
        if constexpr (ALIGN_EPI) { if (wr == 1) PG8_BAR; }
    }
    PG8_WAIT_V(0);
    if constexpr (!ALIGN_EPI) { if (wr == 0) PG8_BAR; }
    PG8_BAR;
    if constexpr (Epi::AFTER_DRAIN) { E.fused(acc, cur, wr, wc, fr, fq, lds, wid, lane); S.done(cur); }
#undef PG8_SA
#undef PG8_SB
#undef PG8_STAGE
#undef PG8_LDA
#undef PG8_LDB
#undef PG8_MMA
#undef PG8_WAIT_V
#undef PG8_WAIT_L
#undef PG8_BAR
#undef PG8_SCHED
}
}

typedef unsigned short bf16;
typedef unsigned v4u __attribute__((ext_vector_type(4)));
typedef float f32x4 __attribute__((ext_vector_type(4)));
#define GAS __attribute__((address_space(1)))
#define LAS __attribute__((address_space(3)))
constexpr int M = 16384, SEQ = 4096, D = 1024, DFF = 2816, NGU = 5632, NIN = 3072, NQKV = 1536, NH = 16, NKV = 4, HD = 64, WIN = 128;
constexpr float EPS = 1e-6f;
constexpr size_t MiB = 1u << 20;
constexpr size_t WS_CTL = 0, WS_ROPE = 1 * MiB;
constexpr size_t WS_WIN = 2 * MiB, WS_WOUT = 8 * MiB, WS_WGU0 = 10 * MiB, WS_WGU1 = 21 * MiB, WS_WDN0 = 32 * MiB, WS_WDN1 = WS_WDN0 + 5632 * 1024, WS_WQKV = 43 * MiB, WS_WO = 46 * MiB;
constexpr size_t WS_XN = 48 * MiB, WS_BIG = 80 * MiB, WS_F32 = 176 * MiB, WS_END = 240 * MiB;

__device__ __forceinline__ unsigned f2bf(float f) { unsigned u = __builtin_bit_cast(unsigned, f); return (u + 0x7fffu + ((u >> 16) & 1u)) >> 16; }
__device__ __forceinline__ unsigned pk2(float lo, float hi) { return f2bf(lo) | (f2bf(hi) << 16); }
__device__ __forceinline__ float bf_lo(unsigned w) { return __builtin_bit_cast(float, w << 16); }
__device__ __forceinline__ float bf_hi(unsigned w) { return __builtin_bit_cast(float, w & 0xffff0000u); }
__device__ __forceinline__ float wave_sum(float v) {
#pragma unroll
    for (int o = 1; o < 64; o <<= 1) v += __shfl_xor(v, o);
    return v;
}

struct CvtJob { const float* W; const float* gain; bf16* dst; int K, N, mode, row_off; };
constexpr int NJOBS = 9;
struct CvtArgs { CvtJob job[NJOBS]; };
__device__ __forceinline__ int dst_row(int mode, int row_off, int n) {
    if (mode == 0) return row_off + n;
    const int half = n >= DFF ? 1 : 0, f = n - half * DFF; return 256 * (f >> 7) + 128 * half + (f & 127);
}
__device__ __forceinline__ void cvt_item(const CvtJob& J, LAS float* scr, int item, int lane) {
    const int K = J.K, N = J.N, nblk = N / 32, kb = item / nblk, nb = item % nblk, k0 = 64 * kb, n0 = 32 * nb;
#pragma unroll 8
    for (int i = 0; i < 32; ++i) { const int kk = 2 * i + (lane >> 5); float w = J.W[(size_t)(k0 + kk) * N + n0 + (lane & 31)]; if (J.gain) w *= J.gain[k0 + kk]; scr[kk * 33 + (lane & 31)] = w; }
    asm volatile("s_waitcnt lgkmcnt(0)" ::: "memory");
    const int c = lane & 7; const int r0 = dst_row(J.mode, J.row_off, n0);
#pragma unroll
    for (int j = 0; j < 4; ++j) { const int n = (lane >> 3) + 8 * j; const LAS float* s = scr + (8 * c) * 33 + n;
        v4u o; o.x = pk2(s[0 * 33], s[1 * 33]); o.y = pk2(s[2 * 33], s[3 * 33]); o.z = pk2(s[4 * 33], s[5 * 33]); o.w = pk2(s[6 * 33], s[7 * 33]);
        *(v4u*)(J.dst + (size_t)(r0 + n) * K + k0 + 8 * c) = o; }
    asm volatile("s_waitcnt lgkmcnt(0)" ::: "memory");
}
__global__ void __launch_bounds__(256) k_convert(CvtArgs a) {
    __shared__ float scr_all[4 * 64 * 33];
    const int lane = threadIdx.x & 63, wave = threadIdx.x >> 6;
    LAS float* scr = (LAS float*)scr_all + wave * 64 * 33;
    const int gw = blockIdx.x * 4 + wave, NGW = gridDim.x * 4;
    int total = 0;
#pragma unroll
    for (int j = 0; j < NJOBS; ++j) total += (a.job[j].K / 64) * (a.job[j].N / 32);
    for (int it = gw; it < total; it += NGW) {
        int r = it;
#pragma unroll
        for (int j = 0; j < NJOBS; ++j) { const int ni = (a.job[j].K / 64) * (a.job[j].N / 32); if (r >= 0 && r < ni) { cvt_item(a.job[j], scr, r, lane); } r -= ni; }
    }
}

__device__ __forceinline__ void sincos_d(double a, float& s_out, float& c_out) {
    const double k = __builtin_rint(a * 0.63661977236758134308);
    double r = __builtin_fma(-k, 1.57079632679489655800e+00, a); r = __builtin_fma(-k, 6.12323399573676603587e-17, r);
    const double z = r * r;
    const double s = r + r * z * (-1.66666666666666324348e-01 + z * (8.33333333332248946124e-03 + z * (-1.98412698298579493134e-04 + z * (2.75573137070700676789e-06 + z * (-2.50507602534068634195e-08 + z * 1.58969099521155010221e-10)))));
    const double c = 1.0 - 0.5 * z + z * z * (4.16666666666666019037e-02 + z * (-1.38888888888741095749e-03 + z * (2.48015872894767294178e-05 + z * (-2.75573143513906633035e-07 + z * (2.08757232129817482790e-09 + z * -1.13596475577881948265e-11)))));
    const int q = ((int)k) & 3;
    const double ss = (q == 0) ? s : (q == 1) ? c : (q == 2) ? -s : -c;
    const double cc = (q == 0) ? c : (q == 1) ? -s : (q == 2) ? -c : s;
    s_out = (float)ss; c_out = (float)cc;
}
__device__ __forceinline__ double inv_freq(int i) {
    return i == 0 ? 1.0 : i == 1 ? 1.93922744748685760285e-01 : i == 2 ? 3.76060309308639331705e-02 : i == 3 ? 7.29266473721710932476e-03 : i == 4 ? 1.41421356237309502578e-03
         : i == 5 ? 2.74248175676207299207e-04 : i == 6 ? 5.31829589694498831745e-05 : 1.03133853772124595919e-05;
}
__global__ void __launch_bounds__(256) k_rope_table(float* cs) {
    const int idx = blockIdx.x * 256 + threadIdx.x; if (idx >= SEQ * 8) return;
    const int pos = idx >> 3, i = idx & 7; float s, c; sincos_d((double)pos * inv_freq(i), s, c);
    cs[idx] = c; cs[SEQ * 8 + idx] = s;
}

struct NormArgs { const float* x; bf16* xn; };
__global__ void __launch_bounds__(256) k_rmsnorm(NormArgs a) {
    const int lane = threadIdx.x & 63, row = blockIdx.x * 4 + (threadIdx.x >> 6);
    const f32x4* xr = (const f32x4*)(a.x + (size_t)row * D) + lane;
    f32x4 v[4]; float s = 0.f;
#pragma unroll
    for (int j = 0; j < 4; ++j) { v[j] = xr[64 * j]; s += (v[j].x * v[j].x + v[j].y * v[j].y) + (v[j].z * v[j].z + v[j].w * v[j].w); }
    const float r = 1.0f / sqrtf(wave_sum(s) * (1.f / D) + EPS);
    unsigned long long* o8 = (unsigned long long*)(a.xn + (size_t)row * D) + lane;
#pragma unroll
    for (int j = 0; j < 4; ++j) o8[64 * j] = (unsigned long long)pk2(v[j].x * r, v[j].y * r) | ((unsigned long long)pk2(v[j].z * r, v[j].w * r) << 32);
}
struct ResArgs { const float* y; const float* base; const float* gain; float* out; bf16* xn; };
__global__ void __launch_bounds__(256) k_resnorm(ResArgs a) {
    const int lane = threadIdx.x & 63, row = blockIdx.x * 4 + (threadIdx.x >> 6);
    const f32x4* yr = (const f32x4*)(a.y + (size_t)row * D) + lane; const f32x4* br = (const f32x4*)(a.base + (size_t)row * D) + lane; const f32x4* gr = (const f32x4*)a.gain + lane;
    f32x4 v[4]; float s = 0.f;
#pragma unroll
    for (int j = 0; j < 4; ++j) { v[j] = yr[64 * j]; s += (v[j].x * v[j].x + v[j].y * v[j].y) + (v[j].z * v[j].z + v[j].w * v[j].w); }
    const float r = 1.0f / sqrtf(wave_sum(s) * (1.f / D) + EPS);
    float s2 = 0.f;
#pragma unroll
    for (int j = 0; j < 4; ++j) { v[j] = br[64 * j] + (v[j] * r) * gr[64 * j]; s2 += (v[j].x * v[j].x + v[j].y * v[j].y) + (v[j].z * v[j].z + v[j].w * v[j].w); }
    f32x4* orow = (f32x4*)(a.out + (size_t)row * D) + lane;
#pragma unroll
    for (int j = 0; j < 4; ++j) orow[64 * j] = v[j];
    if (a.xn) {
        const float r2 = 1.0f / sqrtf(wave_sum(s2) * (1.f / D) + EPS);
        unsigned long long* o8 = (unsigned long long*)(a.xn + (size_t)row * D) + lane;
#pragma unroll
        for (int j = 0; j < 4; ++j) o8[64 * j] = (unsigned long long)pk2(v[j].x * r2, v[j].y * r2) | ((unsigned long long)pk2(v[j].z * r2, v[j].w * r2) << 32);
    }
}
struct ConvArgs { const bf16* bcx; const float* cw; bf16* y; };
__global__ void __launch_bounds__(128) k_conv(ConvArgs a) {
    const int d0 = threadIdx.x * 8, r0 = blockIdx.x * 32, pos0 = r0 & (SEQ - 1);
    float w0[8], w1[8], w2[8], p1[8], p2[8];
#pragma unroll
    for (int i = 0; i < 8; ++i) { w0[i] = a.cw[d0 + i]; w1[i] = a.cw[D + d0 + i]; w2[i] = a.cw[2 * D + d0 + i]; p1[i] = 0.f; p2[i] = 0.f; }
    if (pos0 != 0) {
#pragma unroll
        for (int q = 2; q >= 1; --q) { const bf16* rp = a.bcx + (size_t)(r0 - q) * NIN; const v4u c = *(const v4u*)(rp + D + d0), u = *(const v4u*)(rp + 2 * D + d0);
            float cu[8]; cu[0] = bf_lo(c.x) * bf_lo(u.x); cu[1] = bf_hi(c.x) * bf_hi(u.x); cu[2] = bf_lo(c.y) * bf_lo(u.y); cu[3] = bf_hi(c.y) * bf_hi(u.y);
            cu[4] = bf_lo(c.z) * bf_lo(u.z); cu[5] = bf_hi(c.z) * bf_hi(u.z); cu[6] = bf_lo(c.w) * bf_lo(u.w); cu[7] = bf_hi(c.w) * bf_hi(u.w);
#pragma unroll
            for (int i = 0; i < 8; ++i) { if (q == 2) p2[i] = cu[i]; else p1[i] = cu[i]; } }
    }
    for (int t = 0; t < 32; ++t) {
        const bf16* rp = a.bcx + (size_t)(r0 + t) * NIN; const v4u b = *(const v4u*)(rp + d0), c = *(const v4u*)(rp + D + d0), u = *(const v4u*)(rp + 2 * D + d0);
        float cu[8], bb[8], y[8];
        cu[0] = bf_lo(c.x) * bf_lo(u.x); cu[1] = bf_hi(c.x) * bf_hi(u.x); cu[2] = bf_lo(c.y) * bf_lo(u.y); cu[3] = bf_hi(c.y) * bf_hi(u.y);
        cu[4] = bf_lo(c.z) * bf_lo(u.z); cu[5] = bf_hi(c.z) * bf_hi(u.z); cu[6] = bf_lo(c.w) * bf_lo(u.w); cu[7] = bf_hi(c.w) * bf_hi(u.w);
        bb[0] = bf_lo(b.x); bb[1] = bf_hi(b.x); bb[2] = bf_lo(b.y); bb[3] = bf_hi(b.y); bb[4] = bf_lo(b.z); bb[5] = bf_hi(b.z); bb[6] = bf_lo(b.w); bb[7] = bf_hi(b.w);
#pragma unroll
        for (int i = 0; i < 8; ++i) { y[i] = bb[i] * (w0[i] * p2[i] + w1[i] * p1[i] + w2[i] * cu[i]); p2[i] = p1[i]; p1[i] = cu[i]; }
        v4u o; o.x = pk2(y[0], y[1]); o.y = pk2(y[2], y[3]); o.z = pk2(y[4], y[5]); o.w = pk2(y[6], y[7]);
        *(v4u*)(a.y + (size_t)(r0 + t) * D + d0) = o;
    }
}
struct RopeArgs { bf16* qkv; const float* cs; };
__global__ void __launch_bounds__(256) k_rope(RopeArgs a) {
    const int idx = blockIdx.x * 256 + threadIdx.x;
    const int i = idx & 7, hs = (idx >> 3) % 20, row = idx / 160; if (row >= M) return;
    const int pos = row & (SEQ - 1); const float c = a.cs[pos * 8 + i], s = a.cs[SEQ * 8 + pos * 8 + i];
    bf16* p = a.qkv + (size_t)row * NQKV + (hs < 16 ? hs * 64 : 1024 + (hs - 16) * 64) + i;
    const float x1 = __builtin_bit_cast(float, (unsigned)p[0] << 16), x2 = __builtin_bit_cast(float, (unsigned)p[8] << 16);
    p[0] = (bf16)f2bf(x1 * c - x2 * s); p[8] = (bf16)f2bf(x2 * c + x1 * s);
}
struct AttnArgs { const bf16* qkv; const float* sinks; bf16* out; };
__global__ void __launch_bounds__(256) k_attn(AttnArgs a) {
    __shared__ v4u Ks[192 * 8], Vs[192 * 8];
    const int tid = threadIdx.x, t0 = blockIdx.x * 64, g = blockIdx.y, b = blockIdx.z;
    const size_t rowb = (size_t)b * SEQ;
    for (int e = tid; e < 192 * 8; e += 256) { const int r = e >> 3, ch = e & 7, j = t0 - 128 + r;
        v4u kk = (v4u){0u, 0u, 0u, 0u}, vv = kk;
        if (j >= 0) { const bf16* rp = a.qkv + (rowb + j) * NQKV; kk = *(const v4u*)(rp + 1024 + g * 64 + ch * 8); vv = *(const v4u*)(rp + 1280 + g * 64 + ch * 8); }
        Ks[e] = kk; Vs[e] = vv; }
    __syncthreads();
    const int hq = tid >> 6, qi = tid & 63, t = t0 + qi, h = g * 4 + hq;
    float q[64], o[64];
    { const v4u* qp = (const v4u*)(a.qkv + (rowb + t) * NQKV + h * 64);
#pragma unroll
      for (int c = 0; c < 8; ++c) { const v4u w = qp[c]; q[8 * c] = bf_lo(w.x); q[8 * c + 1] = bf_hi(w.x); q[8 * c + 2] = bf_lo(w.y); q[8 * c + 3] = bf_hi(w.y); q[8 * c + 4] = bf_lo(w.z); q[8 * c + 5] = bf_hi(w.z); q[8 * c + 6] = bf_lo(w.w); q[8 * c + 7] = bf_hi(w.w); } }
#pragma unroll
    for (int d = 0; d < 64; ++d) o[d] = 0.f;
    float m = a.sinks[h], l = 1.0f;
    for (int r = 1; r < 192; ++r) {
        const int j = t0 - 128 + r; const bool valid = (j >= 0) && (j <= t) && (t - j < WIN);
        float s = 0.f;
#pragma unroll
        for (int c = 0; c < 8; ++c) { const v4u w = Ks[r * 8 + c];
            s += q[8 * c] * bf_lo(w.x) + q[8 * c + 1] * bf_hi(w.x) + q[8 * c + 2] * bf_lo(w.y) + q[8 * c + 3] * bf_hi(w.y) + q[8 * c + 4] * bf_lo(w.z) + q[8 * c + 5] * bf_hi(w.z) + q[8 * c + 6] * bf_lo(w.w) + q[8 * c + 7] * bf_hi(w.w); }
        s = valid ? s * 0.125f : -1e30f;
        const float mn = fmaxf(m, s), alpha = __expf(m - mn), p = __expf(s - mn);
        l = l * alpha + p; m = mn;
#pragma unroll
        for (int c = 0; c < 8; ++c) { const v4u w = Vs[r * 8 + c];
            o[8 * c] = o[8 * c] * alpha + p * bf_lo(w.x); o[8 * c + 1] = o[8 * c + 1] * alpha + p * bf_hi(w.x); o[8 * c + 2] = o[8 * c + 2] * alpha + p * bf_lo(w.y); o[8 * c + 3] = o[8 * c + 3] * alpha + p * bf_hi(w.y);
            o[8 * c + 4] = o[8 * c + 4] * alpha + p * bf_lo(w.z); o[8 * c + 5] = o[8 * c + 5] * alpha + p * bf_hi(w.z); o[8 * c + 6] = o[8 * c + 6] * alpha + p * bf_lo(w.w); o[8 * c + 7] = o[8 * c + 7] * alpha + p * bf_hi(w.w); }
    }
    const float il = 1.0f / l;
    v4u* op = (v4u*)(a.out + (rowb + t) * D + h * 64);
#pragma unroll
    for (int c = 0; c < 8; ++c) { v4u w; w.x = pk2(o[8 * c] * il, o[8 * c + 1] * il); w.y = pk2(o[8 * c + 2] * il, o[8 * c + 3] * il); w.z = pk2(o[8 * c + 4] * il, o[8 * c + 5] * il); w.w = pk2(o[8 * c + 6] * il, o[8 * c + 7] * il); op[c] = w; }
}

struct GemmArgs { const bf16* A; const bf16* Bt; void* out; int Mr, N, K, ldc; };
template <int KIND> __global__ void __launch_bounds__(512, 2) k_gemm(GemmArgs a) {
    extern __shared__ __attribute__((aligned(16))) unsigned char lds[];
    pg8::Gemm g{a.A, a.Bt, a.Mr, a.N, a.K}; pg8::StaticOrder S; S.init(a.Mr, a.N, (int)gridDim.x, (int)blockIdx.x);
    if constexpr (KIND == 0) { pg8::EpiBf16<0> E{(bf16*)a.out, a.ldc, nullptr, 0, 0, 1.f}; pg8::gemm_phase<pg8::EpiBf16<0>, pg8::StaticOrder, true, true>((PG8_LAS unsigned char*)lds, g, S, E); }
    else if constexpr (KIND == 1) { pg8::EpiF32 E{(float*)a.out, a.ldc}; pg8::gemm_phase<pg8::EpiF32, pg8::StaticOrder, true, true>((PG8_LAS unsigned char*)lds, g, S, E); }
    else { pg8::EpiSwiGLU E{(bf16*)a.out, a.ldc}; pg8::gemm_phase<pg8::EpiSwiGLU, pg8::StaticOrder, true, true>((PG8_LAS unsigned char*)lds, g, S, E); }
}
constexpr int GEMM_LDS = 131072;
template <int KIND> static void launch_gemm(const bf16* A, const bf16* Bt, void* out, int N, int K, int ldc, hipStream_t s) {
    GemmArgs a; memset(&a, 0, sizeof a); a.A = A; a.Bt = Bt; a.out = out; a.Mr = M; a.N = N; a.K = K; a.ldc = ldc;
    hipLaunchKernelGGL(k_gemm<KIND>, dim3(256), dim3(512), GEMM_LDS, s, a);
}

extern "C" void kernel_launch(void* const* d_in, const int* in_sizes, int n_in, void* d_out, int out_size, void* d_ws, size_t ws_size, hipStream_t stream) {
    static int inited = 0;
    if (!inited) {
        if (n_in != 17 || in_sizes[0] != M * D || out_size != M * D || ws_size < WS_END) { fprintf(stderr, "kernel_launch: unexpected shapes (n_in %d in0 %d out %d ws %zu)\n", n_in, n_in > 0 ? in_sizes[0] : -1, out_size, ws_size); inited = -1; return; }
        hipFuncSetAttribute((const void*)k_gemm<0>, hipFuncAttributeMaxDynamicSharedMemorySize, GEMM_LDS);
        hipFuncSetAttribute((const void*)k_gemm<1>, hipFuncAttributeMaxDynamicSharedMemorySize, GEMM_LDS);
        hipFuncSetAttribute((const void*)k_gemm<2>, hipFuncAttributeMaxDynamicSharedMemorySize, GEMM_LDS);
        inited = 1;
    }
    if (inited < 0) return;
    const float* x = (const float*)d_in[0]; const float* a_pre = (const float*)d_in[1]; const float* a_win = (const float*)d_in[2]; const float* a_cw = (const float*)d_in[3];
    const float* a_wout = (const float*)d_in[4]; const float* a_post = (const float*)d_in[5]; const float* f_pre = (const float*)d_in[6]; const float* f_wgu = (const float*)d_in[7];
    const float* f_wdn = (const float*)d_in[8]; const float* f_post = (const float*)d_in[9]; const float* kv_norm = (const float*)d_in[10]; const float* w_kv = (const float*)d_in[11];
    const float* b_pre = (const float*)d_in[12]; const float* b_wq = (const float*)d_in[13]; const float* b_sinks = (const float*)d_in[14]; const float* b_wo = (const float*)d_in[15]; const float* b_post = (const float*)d_in[16];
    unsigned char* ws = (unsigned char*)d_ws; float* out = (float*)d_out;
    bf16 *Win = (bf16*)(ws + WS_WIN), *Wout = (bf16*)(ws + WS_WOUT), *Wgu0 = (bf16*)(ws + WS_WGU0), *Wgu1 = (bf16*)(ws + WS_WGU1), *Wdn0 = (bf16*)(ws + WS_WDN0), *Wdn1 = (bf16*)(ws + WS_WDN1), *Wqkv = (bf16*)(ws + WS_WQKV), *Wo = (bf16*)(ws + WS_WO);
    bf16 *XN = (bf16*)(ws + WS_XN), *BIG = (bf16*)(ws + WS_BIG); float* F32 = (float*)(ws + WS_F32); float* cs = (float*)(ws + WS_ROPE);
    bf16* ATT = (bf16*)(ws + WS_BIG + 48 * MiB);
    { CvtArgs c; memset(&c, 0, sizeof c);
      c.job[0] = CvtJob{a_win, a_pre, Win, D, NIN, 0, 0};
      c.job[1] = CvtJob{a_wout, nullptr, Wout, D, D, 0, 0};
      c.job[2] = CvtJob{f_wgu, f_pre, Wgu0, D, NGU, 1, 0};
      c.job[3] = CvtJob{f_wgu + (size_t)D * NGU, f_pre + D, Wgu1, D, NGU, 1, 0};
      c.job[4] = CvtJob{f_wdn, nullptr, Wdn0, DFF, D, 0, 0};
      c.job[5] = CvtJob{f_wdn + (size_t)DFF * D, nullptr, Wdn1, DFF, D, 0, 0};
      c.job[6] = CvtJob{b_wq, b_pre, Wqkv, D, D, 0, 0};
      c.job[7] = CvtJob{w_kv, kv_norm, Wqkv, D, 512, 0, 1024};
      c.job[8] = CvtJob{b_wo, nullptr, Wo, D, D, 0, 0};
      hipLaunchKernelGGL(k_convert, dim3(1024), dim3(256), 0, stream, c); }
    hipLaunchKernelGGL(k_rope_table, dim3(SEQ * 8 / 256), dim3(256), 0, stream, cs);
    { NormArgs n; memset(&n, 0, sizeof n); n.x = x; n.xn = XN; hipLaunchKernelGGL(k_rmsnorm, dim3(M / 4), dim3(256), 0, stream, n); }
    launch_gemm<0>(XN, Win, BIG, NIN, D, NIN, stream);
    { ConvArgs c; memset(&c, 0, sizeof c); c.bcx = BIG; c.cw = a_cw; c.y = XN; hipLaunchKernelGGL(k_conv, dim3(M / 32), dim3(128), 0, stream, c); }
    launch_gemm<1>(XN, Wout, F32, D, D, D, stream);
    { ResArgs r; memset(&r, 0, sizeof r); r.y = F32; r.base = x; r.gain = a_post; r.out = out; r.xn = XN; hipLaunchKernelGGL(k_resnorm, dim3(M / 4), dim3(256), 0, stream, r); }
    launch_gemm<2>(XN, Wgu0, BIG, NGU, D, DFF, stream);
    launch_gemm<1>(BIG, Wdn0, F32, D, DFF, D, stream);
    { ResArgs r; memset(&r, 0, sizeof r); r.y = F32; r.base = out; r.gain = f_post; r.out = out; r.xn = XN; hipLaunchKernelGGL(k_resnorm, dim3(M / 4), dim3(256), 0, stream, r); }
    launch_gemm<0>(XN, Wqkv, BIG, NQKV, D, NQKV, stream);
    { RopeArgs r; memset(&r, 0, sizeof r); r.qkv = BIG; r.cs = cs; hipLaunchKernelGGL(k_rope, dim3(M * 160 / 256), dim3(256), 0, stream, r); }
    { AttnArgs t; memset(&t, 0, sizeof t); t.qkv = BIG; t.sinks = b_sinks; t.out = ATT; hipLaunchKernelGGL(k_attn, dim3(SEQ / 64, NKV, 4), dim3(256), 0, stream, t); }
    launch_gemm<1>(ATT, Wo, F32, D, D, D, stream);
    { ResArgs r; memset(&r, 0, sizeof r); r.y = F32; r.base = out; r.gain = b_post; r.out = out; r.xn = XN; hipLaunchKernelGGL(k_resnorm, dim3(M / 4), dim3(256), 0, stream, r); }
    launch_gemm<2>(XN, Wgu1, BIG, NGU, D, DFF, stream);
    launch_gemm<1>(BIG, Wdn1, F32, D, DFF, D, stream);
    { ResArgs r; memset(&r, 0, sizeof r); r.y = F32; r.base = out; r.gain = f_post + D; r.out = out; r.xn = nullptr; hipLaunchKernelGGL(k_resnorm, dim3(M / 4), dim3(256), 0, stream, r); }
}
```

```cpp
#include <cstring>
#include <hip/hip_runtime.h>
#include <cstdio>
#include <cstdint>
namespace pg8 {
#define PG8_LAS __attribute__((address_space(3)))
typedef unsigned short bf16_t;
typedef short bf16x8 __attribute__((ext_vector_type(8)));
typedef float f32x4 __attribute__((ext_vector_type(4)));
typedef unsigned u32x4 __attribute__((ext_vector_type(4)));
constexpr int BM = 256, BK = 64, HALF = 128, HTB = HALF * BK * 2  , STAGE_BYTES = 8 * HTB, NXCD = 8, WGM = 8;

__host__ __device__ __forceinline__ int lds_byte(int r, int c) { const int st = (r >> 4) * 2 + (c >> 5), rr = r & 15, cc = c & 31, ob = rr * 64 + cc * 2; return st * 1024 + (ob ^ (((ob >> 9) & 1) << 5)); }
__host__ __device__ __forceinline__ void stage_rc(int b, int& R, int& C) { const int st = b / 1024, sb = b % 1024, swz = sb ^ (((sb >> 9) & 1) << 5); R = (st >> 1) * 16 + swz / 64; C = (st & 1) * 32 + (swz % 64) / 2; }
__host__ __device__ __forceinline__ int perm32(int rho) { const int n = rho >> 4, i = rho & 15; return 8 * (i >> 2) + 4 * n + (i & 3); }

struct Unit { int pm, pn; };
struct Gemm { const bf16_t* A; const bf16_t* Bt; int M, N, K; };

struct StaticOrder {
    int nM, nN, nwg, G, c;
    __host__ __device__ void init(int M, int N, int G_, int c_) { nM = M / BM; nN = N / BM; nwg = nM * nN; G = G_; c = c_; }
    __host__ __device__ bool next(int i, Unit& u) const {
        const long L = (long)i * G + c; if (L >= nwg) return false;
        int wgid = (int)L; { const int q = nwg / NXCD, r = nwg % NXCD, xcd = wgid % NXCD, off = wgid / NXCD; wgid = (xcd < r ? xcd * (q + 1) : r * (q + 1) + (xcd - r) * q) + off; }
        const int nig = WGM * nN, gid = wgid / nig, fm = gid * WGM, gsz = (nM - fm) < WGM ? (nM - fm) : WGM;
        u.pm = fm + ((wgid % nig) % gsz); u.pn = (wgid % nig) / gsz; return true;
    }
    __device__ __forceinline__ void a_ready(const Unit&) const {}
    __device__ __forceinline__ void done(const Unit&) const {}
};

__device__ __forceinline__ unsigned cvt_pk_bf16(float lo, float hi) { unsigned r; asm volatile("v_cvt_pk_bf16_f32 %0, %1, %2" : "=v"(r) : "v"(lo), "v"(hi)); return r; }
typedef float f32x2 __attribute__((ext_vector_type(2)));
__device__ __forceinline__ f32x2 gelu_pk(f32x2 v) {
    const f32x2 av = __builtin_elementwise_abs(v), d = av * 0.2316418882f + 1.0f;
    f32x2 t; t.x = __builtin_amdgcn_rcpf(d.x); t.y = __builtin_amdgcn_rcpf(d.y);
    f32x2 q = t * 0.5307027145f + (-0.7265760135f); q = q * t + 0.7107068705f; q = q * t + (-0.142248368f); q = q * t + 0.127414796f; q = q * t;
    const f32x2 s = (v * v) * (-0.72134752044f);
    f32x2 e; e.x = __builtin_amdgcn_exp2f(s.x); e.y = __builtin_amdgcn_exp2f(s.y);
    const f32x2 m = v * (q * e), r = v - m;
    f32x2 o; o.x = v.x < 0.f ? m.x : r.x; o.y = v.y < 0.f ? m.y : r.y; return o;
}

template <int ACT  > struct EpiBf16 {
    static constexpr bool PERM = true, AFTER_DRAIN = false; static_assert(ACT == 0 || ACT == 1, "EpiBf16: ACT is 0 (none) or 1 (gelu_pk)");
    bf16_t* O; int ldc; const float* bias; int split_cols; size_t split_stride; float scale0;
    __device__ __forceinline__ void operator()(const f32x4 (&acc)[2][2][4][2], const Unit& u, int wr, int wc, int fr, int fq) const {
        const int row0 = u.pm * BM + wr * 64 + fr; int colt = u.pn * BM; bf16_t* base = O;
        float sc = 1.f; if (split_cols) { const int t = colt / split_cols; base += (size_t)t * split_stride; colt -= t * split_cols; if (t == 0) sc = scale0; }
        const int col0 = colt + wc * 32 + 8 * fq, bcol0 = u.pn * BM + wc * 32 + 8 * fq;
        f32x4 bv[2][2];
#pragma unroll
        for (int bj = 0; bj < 2; ++bj)
#pragma unroll
            for (int n = 0; n < 2; ++n) bv[bj][n] = bias ? *(const f32x4*)(bias + bcol0 + bj * HALF + 4 * n) : (f32x4){0.f, 0.f, 0.f, 0.f};
#pragma unroll
        for (int ai = 0; ai < 2; ++ai)
#pragma unroll
            for (int m = 0; m < 4; ++m) { bf16_t* rowp = base + (size_t)(row0 + ai * HALF + m * 16) * ldc + col0;
#pragma unroll
                for (int bj = 0; bj < 2; ++bj) { f32x4 v0 = acc[ai][bj][m][0] + bv[bj][0], v1 = acc[ai][bj][m][1] + bv[bj][1];
                    if (ACT == 1) { f32x2 a = gelu_pk((f32x2){v0[0], v0[1]}), b = gelu_pk((f32x2){v0[2], v0[3]}), c = gelu_pk((f32x2){v1[0], v1[1]}), d = gelu_pk((f32x2){v1[2], v1[3]});
                        v0 = (f32x4){a.x, a.y, b.x, b.y}; v1 = (f32x4){c.x, c.y, d.x, d.y}; }
                    v0 = v0 * sc; v1 = v1 * sc; u32x4 w; w.x = cvt_pk_bf16(v0[0], v0[1]); w.y = cvt_pk_bf16(v0[2], v0[3]); w.z = cvt_pk_bf16(v1[0], v1[1]); w.w = cvt_pk_bf16(v1[2], v1[3]);
                    *(u32x4*)(rowp + bj * HALF) = w; } }
    }
};
struct EpiF32 {
    static constexpr bool PERM = false, AFTER_DRAIN = false;
    float* C; int ldc;
    __device__ __forceinline__ void operator()(const f32x4 (&acc)[2][2][4][2], const Unit& u, int wr, int wc, int fr, int fq) const {
        const int row0 = u.pm * BM + wr * 64 + fr, col0 = u.pn * BM + wc * 32 + 4 * fq;
#pragma unroll
        for (int ai = 0; ai < 2; ++ai)
#pragma unroll
            for (int m = 0; m < 4; ++m) { float* rowp = C + (size_t)(row0 + ai * HALF + m * 16) * ldc + col0;
#pragma unroll
                for (int bj = 0; bj < 2; ++bj)
#pragma unroll
                    for (int n = 0; n < 2; ++n) *(f32x4*)(rowp + bj * HALF + n * 16) = acc[ai][bj][m][n]; }
    }
};
__device__ __forceinline__ float silu_mul(float g, float u) { return g * u * __builtin_amdgcn_rcpf(1.0f + __builtin_amdgcn_exp2f(-1.4426950408889634f * g)); }
struct EpiSwiGLU {
    static constexpr bool PERM = true, AFTER_DRAIN = false;
    bf16_t* O; int ldc;
    __device__ __forceinline__ void operator()(const f32x4 (&acc)[2][2][4][2], const Unit& u, int wr, int wc, int fr, int fq) const {
        const int row0 = u.pm * BM + wr * 64 + fr, col0 = u.pn * HALF + wc * 32 + 8 * fq;
#pragma unroll
        for (int ai = 0; ai < 2; ++ai)
#pragma unroll
            for (int m = 0; m < 4; ++m) { bf16_t* rowp = O + (size_t)(row0 + ai * HALF + m * 16) * ldc + col0;
                const f32x4 g0 = acc[ai][0][m][0], g1 = acc[ai][0][m][1], u0 = acc[ai][1][m][0], u1 = acc[ai][1][m][1];
                u32x4 w; w.x = cvt_pk_bf16(silu_mul(g0[0], u0[0]), silu_mul(g0[1], u0[1])); w.y = cvt_pk_bf16(silu_mul(g0[2], u0[2]), silu_mul(g0[3], u0[3]));
                w.z = cvt_pk_bf16(silu_mul(g1[0], u1[0]), silu_mul(g1[1], u1[1])); w.w = cvt_pk_bf16(silu_mul(g1[2], u1[2]), silu_mul(g1[3], u1[3]));
                *(u32x4*)rowp = w; }
    }
};
template <class Epi, class Sched, bool ALIGN_EPI = false, bool SP2 = false>
__device__ __forceinline__ void gemm_phase(PG8_LAS unsigned char* lds, const Gemm g, const Sched& S, const Epi& E) {
    const int tid = threadIdx.x, wid = __builtin_amdgcn_readfirstlane(tid >> 6), lane = tid & 63, wr = wid >> 2, wc = wid & 3, fr = lane & 15, fq = lane >> 4;
    const int K = g.K, nt = K / BK;
    unsigned voffA[2], voffB[2];
#pragma unroll
    for (int i = 0; i < 2; ++i) { int R, C; stage_rc(tid * 16 + i * 8192, R, C); const int Rb = Epi::PERM ? ((R & ~31) + perm32(R & 31)) : R;
        voffA[i] = (unsigned)(R * K + C) * 2u; voffB[i] = (unsigned)(Rb * K + C) * 2u; }
    const size_t kstep = (size_t)(BK * 2);
    const size_t hstep = (size_t)HALF * K * 2;
    const size_t tstep = 2 * hstep;
    const unsigned ldsw = (unsigned)wid * 1024u;
    const int aoff = lds_byte(wr * 64 + fr, fq * 8), boff = lds_byte(wc * 32 + fr, fq * 8);
#define PG8_SA(b, h) (((b) * 2 + (h)) * HTB)
#define PG8_SB(b, h) ((4 + (b) * 2 + (h)) * HTB)
#define PG8_STAGE(bufoff, gbase, voff) do { _Pragma("unroll") for (int _i = 0; _i < 2; ++_i) \
        __builtin_amdgcn_global_load_lds((const unsigned*)((const char*)(gbase) + (voff)[_i]), (PG8_LAS unsigned*)(lds + (bufoff) + ldsw + _i * 8192), 16, 0, 0); } while (0)
#define PG8_LDA(dst, b, h) do { _Pragma("unroll") for (int m = 0; m < 4; ++m) _Pragma("unroll") for (int k = 0; k < 2; ++k) dst[m][k] = *(const PG8_LAS bf16x8*)(lds + PG8_SA(b, h) + aoff + m * 2048 + k * 1024); } while (0)
#define PG8_LDB(dst, b, h) do { _Pragma("unroll") for (int n = 0; n < 2; ++n) _Pragma("unroll") for (int k = 0; k < 2; ++k) dst[n][k] = *(const PG8_LAS bf16x8*)(lds + PG8_SB(b, h) + boff + n * 2048 + k * 1024); } while (0)
#define PG8_MMA(ai, bj, At, Bt) do { __builtin_amdgcn_s_setprio(1); _Pragma("unroll") for (int m = 0; m < 4; ++m) _Pragma("unroll") for (int n = 0; n < 2; ++n) _Pragma("unroll") for (int k = 0; k < 2; ++k) \
        acc[ai][bj][m][n] = __builtin_amdgcn_mfma_f32_16x16x32_bf16(Bt[n][k], At[m][k], acc[ai][bj][m][n], 0, 0, 0); __builtin_amdgcn_s_setprio(0); } while (0)
#define PG8_WAIT_V(n) asm volatile("s_waitcnt vmcnt(" #n ")" ::: "memory")
#define PG8_WAIT_L(n) asm volatile("s_waitcnt lgkmcnt(" #n ")" ::: "memory")
#define PG8_BAR __builtin_amdgcn_s_barrier()
#define PG8_SCHED __builtin_amdgcn_sched_barrier(0)
    Unit cur, nxt; int ui = 0;
    if (!S.next(0, cur)) return;
    f32x4 acc[2][2][4][2];
#pragma unroll
    for (int a = 0; a < 2; ++a)
#pragma unroll
        for (int b = 0; b < 2; ++b)
#pragma unroll
            for (int m = 0; m < 4; ++m)
#pragma unroll
                for (int n = 0; n < 2; ++n) acc[a][b][m][n] = (f32x4){0.f, 0.f, 0.f, 0.f};
    bf16x8 At[4][2], B0[2][2], B1[2][2];
    const char* cA = (const char*)g.A + (size_t)cur.pm * tstep; const char* cB = (const char*)g.Bt + (size_t)cur.pn * tstep;
    S.a_ready(cur);
    if constexpr (SP2) {
        PG8_STAGE(PG8_SB(0, 0), cB, voffB); PG8_STAGE(PG8_SB(0, 1), cB + hstep, voffB); PG8_STAGE(PG8_SA(0, 0), cA, voffA); PG8_STAGE(PG8_SA(0, 1), cA + hstep, voffA);
        if (wr == 1) PG8_BAR;
        PG8_WAIT_V(2); PG8_BAR;
        PG8_STAGE(PG8_SB(1, 0), cB + kstep, voffB); PG8_STAGE(PG8_SA(1, 0), cA + kstep, voffA); PG8_STAGE(PG8_SB(1, 1), cB + hstep + kstep, voffB);
        PG8_WAIT_V(6); PG8_BAR;
    } else {
        PG8_STAGE(PG8_SB(0, 0), cB, voffB); PG8_STAGE(PG8_SA(0, 0), cA, voffA); PG8_STAGE(PG8_SB(0, 1), cB + hstep, voffB); PG8_STAGE(PG8_SA(0, 1), cA + hstep, voffA);
        if (wr == 1) PG8_BAR;
        PG8_WAIT_V(4); PG8_BAR;
        PG8_STAGE(PG8_SB(1, 0), cB + kstep, voffB); PG8_STAGE(PG8_SA(1, 0), cA + kstep, voffA); PG8_STAGE(PG8_SB(1, 1), cB + hstep + kstep, voffB);
        PG8_WAIT_V(6); PG8_BAR;
    }
    for (;;) {
        const bool has_next = S.next(ui + 1, nxt);
        const char* nA = has_next ? (const char*)g.A + (size_t)nxt.pm * tstep : cA; const char* nB = has_next ? (const char*)g.Bt + (size_t)nxt.pn * tstep : cB;
        for (int t = 0; t < nt; t += 2) {
            const bool last = (t == nt - 2);
            const char* a1 = cA + (size_t)(t + 1) * kstep;
            const char* a2 = last ? nA : cA + (size_t)(t + 2) * kstep; const char* b2 = last ? nB : cB + (size_t)(t + 2) * kstep;
            const char* a3 = a2 + kstep; const char* b3 = b2 + kstep;
            if (last && has_next) S.a_ready(nxt);
            if constexpr (SP2) {
            PG8_LDB(B0, 0, 0); PG8_LDB(B1, 0, 1); PG8_SCHED; PG8_LDA(At, 0, 0); PG8_STAGE(PG8_SA(1, 1), a1 + hstep, voffA);
            PG8_WAIT_V(8); PG8_WAIT_L(0); PG8_BAR; PG8_MMA(0, 0, At, B0); PG8_MMA(0, 1, At, B1); PG8_BAR; PG8_SCHED;
            PG8_LDA(At, 0, 1); PG8_STAGE(PG8_SB(0, 0), b2, voffB); PG8_STAGE(PG8_SB(0, 1), b2 + hstep, voffB); PG8_STAGE(PG8_SA(0, 0), a2, voffA);
            PG8_WAIT_V(8); PG8_WAIT_L(0); PG8_BAR; PG8_MMA(1, 0, At, B0); PG8_MMA(1, 1, At, B1); PG8_BAR; PG8_SCHED;
            PG8_LDB(B0, 1, 0); PG8_LDB(B1, 1, 1); PG8_SCHED; PG8_LDA(At, 1, 0); PG8_STAGE(PG8_SA(0, 1), a2 + hstep, voffA);
            PG8_WAIT_V(8); PG8_WAIT_L(0); PG8_BAR; PG8_MMA(0, 0, At, B0); PG8_MMA(0, 1, At, B1); PG8_BAR; PG8_SCHED;
            PG8_LDA(At, 1, 1); PG8_STAGE(PG8_SB(1, 0), b3, voffB); PG8_STAGE(PG8_SB(1, 1), b3 + hstep, voffB); PG8_STAGE(PG8_SA(1, 0), a3, voffA);
            PG8_WAIT_V(8); PG8_WAIT_L(0); PG8_BAR; PG8_MMA(1, 0, At, B0); PG8_MMA(1, 1, At, B1); PG8_BAR; PG8_SCHED;
            } else {
            PG8_LDB(B0, 0, 0); PG8_SCHED; PG8_LDA(At, 0, 0); PG8_STAGE(PG8_SA(1, 1), a1 + hstep, voffA);
            PG8_WAIT_L(8); PG8_BAR; PG8_WAIT_L(0); PG8_MMA(0, 0, At, B0); PG8_BAR; PG8_SCHED;
            PG8_LDB(B1, 0, 1); PG8_STAGE(PG8_SB(0, 0), b2, voffB);
            PG8_BAR; PG8_WAIT_L(0); PG8_MMA(0, 1, At, B1); PG8_BAR;
            PG8_LDA(At, 0, 1); PG8_STAGE(PG8_SA(0, 0), a2, voffA);
            PG8_BAR; PG8_WAIT_L(0); PG8_MMA(1, 0, At, B0); PG8_BAR; PG8_SCHED;
            PG8_STAGE(PG8_SB(0, 1), b2 + hstep, voffB);
            PG8_WAIT_V(6); PG8_BAR; PG8_MMA(1, 1, At, B1); PG8_BAR;
            PG8_LDB(B0, 1, 0); PG8_SCHED; PG8_LDA(At, 1, 0); PG8_STAGE(PG8_SA(0, 1), a2 + hstep, voffA);
            PG8_WAIT_L(8); PG8_BAR; PG8_WAIT_L(0); PG8_MMA(0, 0, At, B0); PG8_BAR; PG8_SCHED;
            PG8_LDB(B1, 1, 1); PG8_STAGE(PG8_SB(1, 0), b3, voffB);
            PG8_BAR; PG8_WAIT_L(0); PG8_MMA(0, 1, At, B1); PG8_BAR;
            PG8_LDA(At, 1, 1); PG8_STAGE(PG8_SA(1, 0), a3, voffA);
            PG8_BAR; PG8_WAIT_L(0); PG8_MMA(1, 0, At, B0); PG8_BAR; PG8_SCHED;
            PG8_STAGE(PG8_SB(1, 1), b3 + hstep, voffB);
            PG8_WAIT_V(6); PG8_BAR; PG8_MMA(1, 1, At, B1); PG8_BAR;
            }
        }
        if constexpr (ALIGN_EPI) { if (wr == 0) PG8_BAR; }
        if constexpr (!Epi::AFTER_DRAIN) { E(acc, cur, wr, wc, fr, fq); S.done(cur); }
        if (!has_next) break;
#pragma unroll
        for (int a = 0; a < 2; ++a)
#pragma unroll
            for (int b = 0; b < 2; ++b)
#pragma unroll
                for (int m = 0; m < 4; ++m)
#pragma unroll
                    for (int n = 0; n < 2; ++n) acc[a][b][m][n] = (f32x4){0.f, 0.f, 0.f, 0.f};
        cur = nxt; cA = nA; cB = nB; ++ui;
        if constexpr (ALIGN_EPI) { if (wr == 1) PG8_BAR; }
    }
    PG8_WAIT_V(0);
    if constexpr (!ALIGN_EPI) { if (wr == 0) PG8_BAR; }
    PG8_BAR;
    if constexpr (Epi::AFTER_DRAIN) { E.fused(acc, cur, wr, wc, fr, fq, lds, wid, lane); S.done(cur); }
#undef PG8_SA
#undef PG8_SB
#undef PG8_STAGE
#undef PG8_LDA
#undef PG8_LDB
#undef PG8_MMA
#undef PG8_WAIT_V
#undef PG8_WAIT_L
#undef PG8_BAR
#undef PG8_SCHED
}
}
#define GAS __attribute__((address_space(1)))
#define LAS __attribute__((address_space(3)))
typedef unsigned short bf16;
typedef unsigned v4u __attribute__((ext_vector_type(4)));
typedef float f32x4 __attribute__((ext_vector_type(4)));
typedef short bf16x8 __attribute__((ext_vector_type(8)));
typedef GAS unsigned gu32;
typedef GAS unsigned long long gu64;
#define RLX_AGENT __ATOMIC_RELAXED, __HIP_MEMORY_SCOPE_AGENT
#define LDS_WAIT() asm volatile("s_waitcnt lgkmcnt(0)" ::: "memory")
#define VM_WAIT() asm volatile("s_waitcnt vmcnt(0)" ::: "memory")
__device__ __forceinline__ unsigned long long rt() { return __builtin_amdgcn_s_memrealtime(); }
__device__ __forceinline__ unsigned f2bf(float f) { unsigned u = __builtin_bit_cast(unsigned, f); return (u + 0x7fffu + ((u >> 16) & 1u)) >> 16; }
__device__ __forceinline__ unsigned pk2(float lo, float hi) { return f2bf(lo) | (f2bf(hi) << 16); }

#define XB_TMO      128
#define XB_XCNT(j)  (256  + 64 * (j))
#define XB_XSUB(j)  (1280 + 64 * (j))
#define XB_XGEN(j)  (2304 + 64 * (j))
#define XB_TOP      3328
#define XB_TOPGEN   3392
#define XCD_BAR_WORDS 3456
#define XB_SPIN_CAP (1u << 18)

__device__ __forceinline__ unsigned xb_ld(unsigned* p)              { return __hip_atomic_load(p, __ATOMIC_RELAXED, __HIP_MEMORY_SCOPE_AGENT); }
__device__ __forceinline__ unsigned xb_add(unsigned* p, unsigned v) { return __hip_atomic_fetch_add(p, v, __ATOMIC_RELAXED, __HIP_MEMORY_SCOPE_AGENT); }
__device__ __forceinline__ unsigned xb_xcc_id() { return (unsigned)__builtin_amdgcn_s_getreg((3 << 11) | 20) & 0xFu; }
#define XB_SPIN(cond, bar) do { unsigned _sp = 0; while (cond) { __builtin_amdgcn_s_sleep(1); \
    if ((++_sp & 255u) == 0u) { if (xb_ld(&(bar)[XB_TMO])) break; if (_sp > XB_SPIN_CAP) { atomicAdd(&(bar)[XB_TMO], 1u); break; } } } } while (0)

struct XcdBarrier {
    unsigned* bar; unsigned x;
    volatile LAS unsigned* st;
};

__device__ __forceinline__ XcdBarrier xcd_barrier_post(unsigned* bar, volatile LAS unsigned* st) {
    XcdBarrier b; b.bar = bar; b.x = xb_xcc_id(); b.st = st;
    if (threadIdx.x == 0) (void)xb_add(&bar[XB_XCNT(b.x)], 1u);
    return b;
}
__device__ __forceinline__ void xcd_barrier_complete(unsigned* bar, unsigned x, unsigned& nloc, unsigned& nx) {
    const unsigned G = gridDim.x * gridDim.y * gridDim.z;
    unsigned sum, cnt, mine, sp = 0u;
    for (;;) {
        sum = 0u; cnt = 0u; mine = 0u;
#pragma unroll
        for (unsigned j = 0; j < 16; ++j) { const unsigned c = xb_ld(&bar[XB_XCNT(j)]); sum += c; cnt += (c > 0u) ? 1u : 0u; mine = (j == x) ? c : mine; }
        if (sum == G) break;
        __builtin_amdgcn_s_sleep(1);
        if ((++sp & 255u) == 0u) { if (xb_ld(&bar[XB_TMO])) break; if (sp > XB_SPIN_CAP) { atomicAdd(&bar[XB_TMO], 1u); break; } }
    }
    nloc = mine > 0u ? mine : 1u; nx = cnt > 0u ? cnt : 1u;
}

__device__ __forceinline__ void xcd_barrier(const XcdBarrier& b) {
    asm volatile("s_waitcnt vmcnt(0)" ::: "memory");
    __syncthreads();
    if (threadIdx.x == 0) {
        unsigned* bar = b.bar;
        __builtin_amdgcn_s_waitcnt(0);
        unsigned nloc = b.st[0], nx = b.st[1];
        if (nloc == 0u) { xcd_barrier_complete(bar, b.x, nloc, nx); b.st[0] = nloc; b.st[1] = nx; }
        const unsigned old = xb_add(&bar[XB_XSUB(b.x)], 1u);
        const unsigned gen = old / nloc;
        if (old + 1u == (gen + 1u) * nloc) {
            __builtin_amdgcn_fence(__ATOMIC_RELEASE, "agent");
            asm volatile("s_waitcnt vmcnt(0)" ::: "memory");
            const unsigned og = xb_add(&bar[XB_TOP], 1u);
            const unsigned tg = og / nx;
            if (og + 1u == (tg + 1u) * nx) xb_add(&bar[XB_TOPGEN], 1u);
            else XB_SPIN(xb_ld(&bar[XB_TOPGEN]) == tg, bar);
            __builtin_amdgcn_fence(__ATOMIC_ACQUIRE, "agent");
            xb_add(&bar[XB_XGEN(b.x)], 1u);
            asm volatile("s_waitcnt vmcnt(0)" ::: "memory");
        } else {
            XB_SPIN(xb_ld(&bar[XB_XGEN(b.x)]) == gen, bar);
            __builtin_amdgcn_fence(__ATOMIC_ACQUIRE, "agent");
            asm volatile("s_waitcnt vmcnt(0)" ::: "memory");
        }
    }
    __syncthreads();
}

constexpr int NWAVES = 8;
constexpr int M = 16384, SEQ = 4096, D = 1024, DFF = 2816, NGU = 5632, NIN = 3072, NQKV = 1536, NH = 16, NKV = 4, HD = 64, WIN = 128;
constexpr float EPS = 1e-6f;
constexpr size_t MiB = 1u << 20;
constexpr size_t WS_CTL = 0, CTL_ZERO_BYTES = 64 * 1024, WS_ROPE = 1 * MiB;
constexpr size_t WS_WIN = 2 * MiB, WS_WOUT = 8 * MiB, WS_WGU0 = 10 * MiB, WS_WGU1 = 21 * MiB, WS_WDN0 = 32 * MiB, WS_WDN1 = WS_WDN0 + 5632 * 1024, WS_WQKV = 43 * MiB, WS_WO = 46 * MiB;
constexpr size_t WS_XN = 48 * MiB, WS_BIG = 80 * MiB, WS_F32 = 176 * MiB, WS_END = 240 * MiB;
constexpr int CW_BAR = 4096;
static_assert((CW_BAR + XCD_BAR_WORDS) * 4 <= (int)CTL_ZERO_BYTES, "control words inside the memset region");
constexpr int RING_OFF = 0, RING_BYTES = 131072, LDSCTL_OFF = RING_BYTES, MISC_OFF = LDSCTL_OFF + 320, LDS_BYTES = 147456;

__device__ __forceinline__ float bf_lo(unsigned w) { return __builtin_bit_cast(float, w << 16); }
__device__ __forceinline__ float bf_hi(unsigned w) { return __builtin_bit_cast(float, w & 0xffff0000u); }
__device__ __forceinline__ float wave_sum(float v) {
#pragma unroll
    for (int o = 1; o < 64; o <<= 1) v += __shfl_xor(v, o);
    return v;
}

__device__ __forceinline__ int dst_row(int mode, int row_off, int n) {
    if (mode == 0) return row_off + n;
    const int half = n >= DFF ? 1 : 0, f = n - half * DFF; return 256 * (f >> 7) + 128 * half + (f & 127);
}
__device__ __forceinline__ void cvt_item(const float* W, const float* gain, bf16* dst, int K, int N, int mode, int row_off, LAS float* scr, int item, int lane) {
    const int nblk = N / 32, kb = item / nblk, nb = item % nblk, k0 = 64 * kb, n0 = 32 * nb;
#pragma unroll 8
    for (int i = 0; i < 32; ++i) { const int kk = 2 * i + (lane >> 5); float w = W[(size_t)(k0 + kk) * N + n0 + (lane & 31)]; if (gain) w *= gain[k0 + kk]; scr[kk * 33 + (lane & 31)] = w; }
    LDS_WAIT(); asm volatile("" ::: "memory");
    const int c = lane & 7; const int r0 = dst_row(mode, row_off, n0);
#pragma unroll
    for (int j = 0; j < 4; ++j) { const int n = (lane >> 3) + 8 * j; const LAS float* s = scr + (8 * c) * 33 + n;
        v4u o; o.x = pk2(s[0 * 33], s[1 * 33]); o.y = pk2(s[2 * 33], s[3 * 33]); o.z = pk2(s[4 * 33], s[5 * 33]); o.w = pk2(s[6 * 33], s[7 * 33]);
        *(v4u*)(dst + (size_t)(r0 + n) * K + k0 + 8 * c) = o; }
    LDS_WAIT(); asm volatile("" ::: "memory");
}
__device__ __forceinline__ void sincos_d(double a, float& s_out, float& c_out) {
    const double k = __builtin_rint(a * 0.63661977236758134308);
    double r = __builtin_fma(-k, 1.57079632679489655800e+00, a); r = __builtin_fma(-k, 6.12323399573676603587e-17, r);
    const double z = r * r;
    const double s = r + r * z * (-1.66666666666666324348e-01 + z * (8.33333333332248946124e-03 + z * (-1.98412698298579493134e-04 + z * (2.75573137070700676789e-06 + z * (-2.50507602534068634195e-08 + z * 1.58969099521155010221e-10)))));
    const double c = 1.0 - 0.5 * z + z * z * (4.16666666666666019037e-02 + z * (-1.38888888888741095749e-03 + z * (2.48015872894767294178e-05 + z * (-2.75573143513906633035e-07 + z * (2.08757232129817482790e-09 + z * -1.13596475577881948265e-11)))));
    const int q = ((int)k) & 3;
    const double ss = (q == 0) ? s : (q == 1) ? c : (q == 2) ? -s : -c;
    const double cc = (q == 0) ? c : (q == 1) ? -s : (q == 2) ? -c : s;
    s_out = (float)ss; c_out = (float)cc;
}
__device__ __forceinline__ double inv_freq(int i) {
    return i == 0 ? 1.0 : i == 1 ? 1.93922744748685760285e-01 : i == 2 ? 3.76060309308639331705e-02 : i == 3 ? 7.29266473721710932476e-03 : i == 4 ? 1.41421356237309502578e-03
         : i == 5 ? 2.74248175676207299207e-04 : i == 6 ? 5.31829589694498831745e-05 : 1.03133853772124595919e-05;
}
__device__ __forceinline__ void rmsnorm_row(const float* xrow, bf16* orow, int lane) {
    const f32x4* xr = (const f32x4*)xrow + lane;
    f32x4 v[4]; float s = 0.f;
#pragma unroll
    for (int j = 0; j < 4; ++j) { v[j] = xr[64 * j]; s += (v[j].x * v[j].x + v[j].y * v[j].y) + (v[j].z * v[j].z + v[j].w * v[j].w); }
    const float r = 1.0f / sqrtf(wave_sum(s) * (1.f / D) + EPS);
    unsigned long long* o8 = (unsigned long long*)orow + lane;
#pragma unroll
    for (int j = 0; j < 4; ++j) o8[64 * j] = (unsigned long long)pk2(v[j].x * r, v[j].y * r) | ((unsigned long long)pk2(v[j].z * r, v[j].w * r) << 32);
}
__device__ __forceinline__ void resnorm_row(const float* yrow, const float* brow, const float* gain, float* orow_f, bf16* xnrow, bool bad, int lane) {
    const f32x4* yr = (const f32x4*)yrow + lane; const f32x4* br = (const f32x4*)brow + lane; const f32x4* gr = (const f32x4*)gain + lane;
    f32x4 v[4]; float s = 0.f;
#pragma unroll
    for (int j = 0; j < 4; ++j) { v[j] = yr[64 * j]; s += (v[j].x * v[j].x + v[j].y * v[j].y) + (v[j].z * v[j].z + v[j].w * v[j].w); }
    const float r = 1.0f / sqrtf(wave_sum(s) * (1.f / D) + EPS);
    float s2 = 0.f;
#pragma unroll
    for (int j = 0; j < 4; ++j) { v[j] = br[64 * j] + (v[j] * r) * gr[64 * j]; s2 += (v[j].x * v[j].x + v[j].y * v[j].y) + (v[j].z * v[j].z + v[j].w * v[j].w); }
    f32x4* orow = (f32x4*)orow_f + lane; const float qn = __builtin_nanf("");
#pragma unroll
    for (int j = 0; j < 4; ++j) orow[64 * j] = bad ? (f32x4){qn, qn, qn, qn} : v[j];
    if (xnrow) {
        const float r2 = 1.0f / sqrtf(wave_sum(s2) * (1.f / D) + EPS);
        unsigned long long* o8 = (unsigned long long*)xnrow + lane;
#pragma unroll
        for (int j = 0; j < 4; ++j) o8[64 * j] = (unsigned long long)pk2(v[j].x * r2, v[j].y * r2) | ((unsigned long long)pk2(v[j].z * r2, v[j].w * r2) << 32);
    }
}
__device__ __forceinline__ void unpack8(const v4u w, float* f) { f[0] = bf_lo(w.x); f[1] = bf_hi(w.x); f[2] = bf_lo(w.y); f[3] = bf_hi(w.y); f[4] = bf_lo(w.z); f[5] = bf_hi(w.z); f[6] = bf_lo(w.w); f[7] = bf_hi(w.w); }
__device__ __forceinline__ void conv_chunk(const bf16* bcx, const float* cw, bf16* y, int chunk, int t128) {
    const int d0 = t128 * 8, r0 = chunk * 16, pos0 = r0 & (SEQ - 1);
    float w0[8], w1[8], w2[8], p1[8], p2[8];
#pragma unroll
    for (int i = 0; i < 8; ++i) { w0[i] = cw[d0 + i]; w1[i] = cw[D + d0 + i]; w2[i] = cw[2 * D + d0 + i]; p1[i] = 0.f; p2[i] = 0.f; }
    if (pos0 != 0) {
        float c8[8], u8[8];
        { const bf16* rp = bcx + (size_t)(r0 - 2) * NIN; unpack8(*(const v4u*)(rp + D + d0), c8); unpack8(*(const v4u*)(rp + 2 * D + d0), u8);
#pragma unroll
          for (int i = 0; i < 8; ++i) p2[i] = c8[i] * u8[i]; }
        { const bf16* rp = bcx + (size_t)(r0 - 1) * NIN; unpack8(*(const v4u*)(rp + D + d0), c8); unpack8(*(const v4u*)(rp + 2 * D + d0), u8);
#pragma unroll
          for (int i = 0; i < 8; ++i) p1[i] = c8[i] * u8[i]; }
    }
    for (int t = 0; t < 16; ++t) {
        const bf16* rp = bcx + (size_t)(r0 + t) * NIN; float b8[8], c8[8], u8[8], yv[8];
        unpack8(*(const v4u*)(rp + d0), b8); unpack8(*(const v4u*)(rp + D + d0), c8); unpack8(*(const v4u*)(rp + 2 * D + d0), u8);
#pragma unroll
        for (int i = 0; i < 8; ++i) { const float cu = c8[i] * u8[i]; yv[i] = b8[i] * (w0[i] * p2[i] + w1[i] * p1[i] + w2[i] * cu); p2[i] = p1[i]; p1[i] = cu; }
        v4u o; o.x = pk2(yv[0], yv[1]); o.y = pk2(yv[2], yv[3]); o.z = pk2(yv[4], yv[5]); o.w = pk2(yv[6], yv[7]);
        *(v4u*)(y + (size_t)(r0 + t) * D + d0) = o;
    }
}
__device__ __forceinline__ void attn_item(const bf16* qkv, const float* sinks, bf16* out, LAS v4u* Ks, LAS v4u* Vs, int item, int tid) {
    const int t0 = (item & 63) * 64, g = (item >> 6) & 3, b = item >> 8;
    const size_t rowb = (size_t)b * SEQ;
    for (int e = tid; e < 192 * 8; e += 256) { const int r = e >> 3, ch = e & 7, j = t0 - 128 + r;
        v4u kk = (v4u){0u, 0u, 0u, 0u}, vv = kk;
        if (j >= 0) { const bf16* rp = qkv + (rowb + j) * NQKV; kk = *(const v4u*)(rp + 1024 + g * 64 + ch * 8); vv = *(const v4u*)(rp + 1280 + g * 64 + ch * 8); }
        Ks[e] = kk; Vs[e] = vv; }
    __syncthreads();
    const int hq = tid >> 6, qi = tid & 63, t = t0 + qi, h = g * 4 + hq;
    float q[64], o[64];
    { const v4u* qp = (const v4u*)(qkv + (rowb + t) * NQKV + h * 64);
#pragma unroll
      for (int c = 0; c < 8; ++c) unpack8(qp[c], q + 8 * c); }
#pragma unroll
    for (int d = 0; d < 64; ++d) o[d] = 0.f;
    float m = sinks[h], l = 1.0f;
    for (int r = 1; r < 192; ++r) {
        const int j = t0 - 128 + r; const bool valid = (j >= 0) && (j <= t) && (t - j < WIN);
        float s = 0.f;
#pragma unroll
        for (int c = 0; c < 8; ++c) { float k8[8]; unpack8(Ks[r * 8 + c], k8);
#pragma unroll
            for (int i = 0; i < 8; ++i) s += q[8 * c + i] * k8[i]; }
        s = valid ? s * 0.125f : -1e30f;
        const float mn = fmaxf(m, s), alpha = __expf(m - mn), p = __expf(s - mn);
        l = l * alpha + p; m = mn;
#pragma unroll
        for (int c = 0; c < 8; ++c) { float v8[8]; unpack8(Vs[r * 8 + c], v8);
#pragma unroll
            for (int i = 0; i < 8; ++i) o[8 * c + i] = o[8 * c + i] * alpha + p * v8[i]; }
    }
    const float il = 1.0f / l;
    v4u* op = (v4u*)(out + (rowb + t) * D + h * 64);
#pragma unroll
    for (int c = 0; c < 8; ++c) { v4u w; w.x = pk2(o[8 * c] * il, o[8 * c + 1] * il); w.y = pk2(o[8 * c + 2] * il, o[8 * c + 3] * il); w.z = pk2(o[8 * c + 4] * il, o[8 * c + 5] * il); w.w = pk2(o[8 * c + 6] * il, o[8 * c + 7] * il); op[c] = w; }
    __syncthreads();
}

struct Args { const float* in[17]; float* out; unsigned char* ws; };
__global__ void __launch_bounds__(NWAVES * 64, 2) fwd(Args args) {
    extern __shared__ __attribute__((aligned(16))) unsigned char lds_raw[];
    LAS unsigned char* lds = (LAS unsigned char*)lds_raw;
    volatile LAS unsigned* MISC = (volatile LAS unsigned*)(lds + MISC_OFF);
    const int tid = threadIdx.x, lane = tid & 63, wave = __builtin_amdgcn_readfirstlane(tid >> 6);
    const int G = gridDim.x, bx = blockIdx.x; const int vcu = (G % 8 == 0) ? (bx % 8) * (G / 8) + bx / 8 : bx;
    unsigned char* ws = args.ws; gu32* ctl = (gu32*)(ws + WS_CTL);
    const float* x = args.in[0]; const float* a_pre = args.in[1]; const float* a_win = args.in[2]; const float* a_cw = args.in[3];
    const float* a_wout = args.in[4]; const float* a_post = args.in[5]; const float* f_pre = args.in[6]; const float* f_wgu = args.in[7];
    const float* f_wdn = args.in[8]; const float* f_post = args.in[9]; const float* kv_norm = args.in[10]; const float* w_kv = args.in[11];
    const float* b_pre = args.in[12]; const float* b_wq = args.in[13]; const float* b_sinks = args.in[14]; const float* b_wo = args.in[15]; const float* b_post = args.in[16];
    float* out = args.out;
    bf16 *Win = (bf16*)(ws + WS_WIN), *Wout = (bf16*)(ws + WS_WOUT), *Wgu0 = (bf16*)(ws + WS_WGU0), *Wgu1 = (bf16*)(ws + WS_WGU1), *Wdn0 = (bf16*)(ws + WS_WDN0), *Wdn1 = (bf16*)(ws + WS_WDN1), *Wqkv = (bf16*)(ws + WS_WQKV), *Wo = (bf16*)(ws + WS_WO);
    bf16 *XN = (bf16*)(ws + WS_XN), *BIG = (bf16*)(ws + WS_BIG); float* F32 = (float*)(ws + WS_F32); float* cs = (float*)(ws + WS_ROPE);
    bf16* ATT = (bf16*)(ws + WS_BIG + 48 * MiB);
    for (int u = tid; u < (LDS_BYTES - LDSCTL_OFF) / 4; u += NWAVES * 64) ((LAS unsigned*)(lds + LDSCTL_OFF))[u] = 0u;
    __syncthreads();
    XcdBarrier bar = xcd_barrier_post((unsigned*)(ctl + CW_BAR), MISC + 8);
    const int gw = vcu * NWAVES + wave, NGW = G * NWAVES;
#define GRID_BAR() xcd_barrier(bar)
#define GEMM_PHASE(EPI, A_, B_, N_, K_, ...) do { pg8::Gemm g{A_, B_, M, N_, K_}; pg8::StaticOrder S; S.init(M, N_, G, bx); pg8::EPI E{__VA_ARGS__}; \
        pg8::gemm_phase<pg8::EPI, pg8::StaticOrder, true, true>(lds + RING_OFF, g, S, E); } while (0)
#define RESNORM_PHASE(Y_, BASE_, GAIN_, OUT_, XN_, BAD_) do { for (int m = gw; m < M; m += NGW) resnorm_row((Y_) + (size_t)m * D, (BASE_) + (size_t)m * D, GAIN_, (OUT_) + (size_t)m * D, (XN_) ? (XN_) + (size_t)m * D : nullptr, BAD_, lane); } while (0)

    {
        LAS float* scr = (LAS float*)(lds + RING_OFF + wave * 16384);
        constexpr int I_IN = (D / 64) * (NIN / 32), I_DD = (D / 64) * (D / 32), I_GU = (D / 64) * (NGU / 32), I_DN = (DFF / 64) * (D / 32), I_KV = (D / 64) * (512 / 32);
        constexpr int NITEMS = I_IN + 3 * I_DD + 2 * I_GU + 2 * I_DN + I_KV;
        for (int it = gw; it < NITEMS; it += NGW) {
            int r = it;
            if (r < I_IN) { cvt_item(a_win, a_pre, Win, D, NIN, 0, 0, scr, r, lane); continue; } r -= I_IN;
            if (r < I_DD) { cvt_item(a_wout, nullptr, Wout, D, D, 0, 0, scr, r, lane); continue; } r -= I_DD;
            if (r < I_GU) { cvt_item(f_wgu, f_pre, Wgu0, D, NGU, 1, 0, scr, r, lane); continue; } r -= I_GU;
            if (r < I_GU) { cvt_item(f_wgu + (size_t)D * NGU, f_pre + D, Wgu1, D, NGU, 1, 0, scr, r, lane); continue; } r -= I_GU;
            if (r < I_DN) { cvt_item(f_wdn, nullptr, Wdn0, DFF, D, 0, 0, scr, r, lane); continue; } r -= I_DN;
            if (r < I_DN) { cvt_item(f_wdn + (size_t)DFF * D, nullptr, Wdn1, DFF, D, 0, 0, scr, r, lane); continue; } r -= I_DN;
            if (r < I_DD) { cvt_item(b_wq, b_pre, Wqkv, D, D, 0, 0, scr, r, lane); continue; } r -= I_DD;
            if (r < I_KV) { cvt_item(w_kv, kv_norm, Wqkv, D, 512, 0, 1024, scr, r, lane); continue; } r -= I_KV;
            cvt_item(b_wo, nullptr, Wo, D, D, 0, 0, scr, r, lane);
        }
        for (int idx = vcu * 512 + tid; idx < SEQ * 8; idx += G * 512) { const int pos = idx >> 3, i = idx & 7; float s, c; sincos_d((double)pos * inv_freq(i), s, c); cs[idx] = c; cs[SEQ * 8 + idx] = s; }
        for (int m = gw; m < M; m += NGW) rmsnorm_row(x + (size_t)m * D, XN + (size_t)m * D, lane);
    }
    GRID_BAR();
    GEMM_PHASE(EpiBf16<0>, XN, Win, NIN, D, BIG, NIN, nullptr, 0, 0, 1.f);
    GRID_BAR();
    for (int ch = bx * 4 + (tid >> 7); ch < M / 16; ch += G * 4) conv_chunk(BIG, a_cw, XN, ch, tid & 127);
    GRID_BAR();
    GEMM_PHASE(EpiF32, XN, Wout, D, D, F32, D);
    GRID_BAR();
    RESNORM_PHASE(F32, x, a_post, out, XN, false);
    GRID_BAR();
    GEMM_PHASE(EpiSwiGLU, XN, Wgu0, NGU, D, BIG, DFF);
    GRID_BAR();
    GEMM_PHASE(EpiF32, BIG, Wdn0, D, DFF, F32, D);
    GRID_BAR();
    RESNORM_PHASE(F32, out, f_post, out, XN, false);
    GRID_BAR();
    GEMM_PHASE(EpiBf16<0>, XN, Wqkv, NQKV, D, BIG, NQKV, nullptr, 0, 0, 1.f);
    GRID_BAR();
    for (int idx = vcu * 512 + tid; idx < M * 160; idx += G * 512) {
        const int i = idx & 7, hs = (idx >> 3) % 20, row = idx / 160, pos = row & (SEQ - 1); const float c = cs[pos * 8 + i], s = cs[SEQ * 8 + pos * 8 + i];
        bf16* p = BIG + (size_t)row * NQKV + (hs < 16 ? hs * 64 : 1024 + (hs - 16) * 64) + i;
        const float x1 = __builtin_bit_cast(float, (unsigned)p[0] << 16), x2 = __builtin_bit_cast(float, (unsigned)p[8] << 16);
        p[0] = (bf16)f2bf(x1 * c - x2 * s); p[8] = (bf16)f2bf(x2 * c + x1 * s);
    }
    GRID_BAR();
    { const int vb = tid >> 8; LAS v4u* Ks = (LAS v4u*)(lds + RING_OFF + vb * 49152); LAS v4u* Vs = Ks + 192 * 8;
      for (int it = (bx * 2 + vb); it < 1024; it += G * 2) attn_item(BIG, b_sinks, ATT, Ks, Vs, it, tid & 255); }
    GRID_BAR();
    GEMM_PHASE(EpiF32, ATT, Wo, D, D, F32, D);
    GRID_BAR();
    RESNORM_PHASE(F32, out, b_post, out, XN, false);
    GRID_BAR();
    GEMM_PHASE(EpiSwiGLU, XN, Wgu1, NGU, D, BIG, DFF);
    GRID_BAR();
    GEMM_PHASE(EpiF32, BIG, Wdn1, D, DFF, F32, D);
    GRID_BAR();
    { const bool bad = __hip_atomic_load((gu32*)(ctl + CW_BAR) + XB_TMO, RLX_AGENT) != 0u;
      bf16* nobf = nullptr; RESNORM_PHASE(F32, out, f_post + D, out, nobf, bad); }
}

extern "C" void kernel_launch(void* const* d_in, const int* in_sizes, int n_in, void* d_out, int out_size, void* d_ws, size_t ws_size, hipStream_t stream) {
    static int grid = 0;
    if (grid == 0) {
        if (n_in != 17 || in_sizes[0] != M * D || out_size != M * D || ws_size < WS_END) { fprintf(stderr, "kernel_launch: unexpected shapes (n_in %d in0 %d out %d ws %zu)\n", n_in, n_in > 0 ? in_sizes[0] : -1, out_size, ws_size); grid = -1; return; }
        int dev = 0, cus = 0, per_cu = 0;
        if (hipGetDevice(&dev) != hipSuccess || hipDeviceGetAttribute(&cus, hipDeviceAttributeMultiprocessorCount, dev) != hipSuccess) { grid = -1; return; }
        if (hipFuncSetAttribute((const void*)fwd, hipFuncAttributeMaxDynamicSharedMemorySize, LDS_BYTES) != hipSuccess) { fprintf(stderr, "kernel_launch: hipFuncSetAttribute failed\n"); grid = -1; return; }
        if (hipOccupancyMaxActiveBlocksPerMultiprocessor(&per_cu, (const void*)fwd, NWAVES * 64, LDS_BYTES) != hipSuccess || per_cu < 1) { fprintf(stderr, "kernel_launch: occupancy query says %d blocks per CU\n", per_cu); }
        (void)hipGetLastError();
        grid = cus;
    }
    if (grid < 0) return;
    if (hipMemsetAsync((char*)d_ws + WS_CTL, 0, CTL_ZERO_BYTES, stream) != hipSuccess) return;
    Args a; memset(&a, 0, sizeof a);
    for (int i = 0; i < 17; ++i) a.in[i] = (const float*)d_in[i];
    a.out = (float*)d_out; a.ws = (unsigned char*)d_ws;
    hipLaunchKernelGGL(fwd, dim3(grid), dim3(NWAVES * 64), LDS_BYTES, stream, a);
}
```

```cpp
#include <cstring>
#include <cmath>
#include <hip/hip_runtime.h>
#include <cstdio>
#include <cstdint>
namespace pg8 {
#define PG8_LAS __attribute__((address_space(3)))
typedef unsigned short bf16_t;
typedef short bf16x8 __attribute__((ext_vector_type(8)));
typedef float f32x4 __attribute__((ext_vector_type(4)));
typedef unsigned u32x4 __attribute__((ext_vector_type(4)));
constexpr int BM = 256, BK = 64, HALF = 128, HTB = HALF * BK * 2  , STAGE_BYTES = 8 * HTB, NXCD = 8, WGM = 8;

__host__ __device__ __forceinline__ int lds_byte(int r, int c) { const int st = (r >> 4) * 2 + (c >> 5), rr = r & 15, cc = c & 31, ob = rr * 64 + cc * 2; return st * 1024 + (ob ^ (((ob >> 9) & 1) << 5)); }
__host__ __device__ __forceinline__ void stage_rc(int b, int& R, int& C) { const int st = b / 1024, sb = b % 1024, swz = sb ^ (((sb >> 9) & 1) << 5); R = (st >> 1) * 16 + swz / 64; C = (st & 1) * 32 + (swz % 64) / 2; }
__host__ __device__ __forceinline__ int perm32(int rho) { const int n = rho >> 4, i = rho & 15; return 8 * (i >> 2) + 4 * n + (i & 3); }

struct Unit { int pm, pn; };
struct Gemm { const bf16_t* A; const bf16_t* Bt; int M, N, K; };

struct StaticOrder {
    int nM, nN, nwg, G, c;
    __host__ __device__ void init(int M, int N, int G_, int c_) { nM = M / BM; nN = N / BM; nwg = nM * nN; G = G_; c = c_; }
    __host__ __device__ bool next(int i, Unit& u) const {
        const long L = (long)i * G + c; if (L >= nwg) return false;
        int wgid = (int)L; { const int q = nwg / NXCD, r = nwg % NXCD, xcd = wgid % NXCD, off = wgid / NXCD; wgid = (xcd < r ? xcd * (q + 1) : r * (q + 1) + (xcd - r) * q) + off; }
        const int nig = WGM * nN, gid = wgid / nig, fm = gid * WGM, gsz = (nM - fm) < WGM ? (nM - fm) : WGM;
        u.pm = fm + ((wgid % nig) % gsz); u.pn = (wgid % nig) / gsz; return true;
    }
    __device__ __forceinline__ void a_ready(const Unit&) const {}
    __device__ __forceinline__ void done(const Unit&) const {}
};

__device__ __forceinline__ unsigned cvt_pk_bf16(float lo, float hi) { unsigned r; asm volatile("v_cvt_pk_bf16_f32 %0, %1, %2" : "=v"(r) : "v"(lo), "v"(hi)); return r; }
typedef float f32x2 __attribute__((ext_vector_type(2)));
__device__ __forceinline__ f32x2 gelu_pk(f32x2 v) {
    const f32x2 av = __builtin_elementwise_abs(v), d = av * 0.2316418882f + 1.0f;
    f32x2 t; t.x = __builtin_amdgcn_rcpf(d.x); t.y = __builtin_amdgcn_rcpf(d.y);
    f32x2 q = t * 0.5307027145f + (-0.7265760135f); q = q * t + 0.7107068705f; q = q * t + (-0.142248368f); q = q * t + 0.127414796f; q = q * t;
    const f32x2 s = (v * v) * (-0.72134752044f);
    f32x2 e; e.x = __builtin_amdgcn_exp2f(s.x); e.y = __builtin_amdgcn_exp2f(s.y);
    const f32x2 m = v * (q * e), r = v - m;
    f32x2 o; o.x = v.x < 0.f ? m.x : r.x; o.y = v.y < 0.f ? m.y : r.y; return o;
}

template <int ACT  > struct EpiBf16 {
    static constexpr bool PERM = true, AFTER_DRAIN = false; static_assert(ACT == 0 || ACT == 1, "EpiBf16: ACT is 0 (none) or 1 (gelu_pk)");
    bf16_t* O; int ldc; const float* bias; int split_cols; size_t split_stride; float scale0;
    __device__ __forceinline__ void operator()(const f32x4 (&acc)[2][2][4][2], const Unit& u, int wr, int wc, int fr, int fq) const {
        const int row0 = u.pm * BM + wr * 64 + fr; int colt = u.pn * BM; bf16_t* base = O;
        float sc = 1.f; if (split_cols) { const int t = colt / split_cols; base += (size_t)t * split_stride; colt -= t * split_cols; if (t == 0) sc = scale0; }
        const int col0 = colt + wc * 32 + 8 * fq, bcol0 = u.pn * BM + wc * 32 + 8 * fq;
        f32x4 bv[2][2];
#pragma unroll
        for (int bj = 0; bj < 2; ++bj)
#pragma unroll
            for (int n = 0; n < 2; ++n) bv[bj][n] = bias ? *(const f32x4*)(bias + bcol0 + bj * HALF + 4 * n) : (f32x4){0.f, 0.f, 0.f, 0.f};
#pragma unroll
        for (int ai = 0; ai < 2; ++ai)
#pragma unroll
            for (int m = 0; m < 4; ++m) { bf16_t* rowp = base + (size_t)(row0 + ai * HALF + m * 16) * ldc + col0;
#pragma unroll
                for (int bj = 0; bj < 2; ++bj) { f32x4 v0 = acc[ai][bj][m][0] + bv[bj][0], v1 = acc[ai][bj][m][1] + bv[bj][1];
                    if (ACT == 1) { f32x2 a = gelu_pk((f32x2){v0[0], v0[1]}), b = gelu_pk((f32x2){v0[2], v0[3]}), c = gelu_pk((f32x2){v1[0], v1[1]}), d = gelu_pk((f32x2){v1[2], v1[3]});
                        v0 = (f32x4){a.x, a.y, b.x, b.y}; v1 = (f32x4){c.x, c.y, d.x, d.y}; }
                    v0 = v0 * sc; v1 = v1 * sc; u32x4 w; w.x = cvt_pk_bf16(v0[0], v0[1]); w.y = cvt_pk_bf16(v0[2], v0[3]); w.z = cvt_pk_bf16(v1[0], v1[1]); w.w = cvt_pk_bf16(v1[2], v1[3]);
                    *(u32x4*)(rowp + bj * HALF) = w; } }
    }
};
struct EpiF32 {
    static constexpr bool PERM = false, AFTER_DRAIN = false;
    float* C; int ldc;
    __device__ __forceinline__ void operator()(const f32x4 (&acc)[2][2][4][2], const Unit& u, int wr, int wc, int fr, int fq) const {
        const int row0 = u.pm * BM + wr * 64 + fr, col0 = u.pn * BM + wc * 32 + 4 * fq;
#pragma unroll
        for (int ai = 0; ai < 2; ++ai)
#pragma unroll
            for (int m = 0; m < 4; ++m) { float* rowp = C + (size_t)(row0 + ai * HALF + m * 16) * ldc + col0;
#pragma unroll
                for (int bj = 0; bj < 2; ++bj)
#pragma unroll
                    for (int n = 0; n < 2; ++n) *(f32x4*)(rowp + bj * HALF + n * 16) = acc[ai][bj][m][n]; }
    }
};
__device__ __forceinline__ float silu_mul(float g, float u) { return g * u * __builtin_amdgcn_rcpf(1.0f + __builtin_amdgcn_exp2f(-1.4426950408889634f * g)); }
struct EpiSwiGLU {
    static constexpr bool PERM = true, AFTER_DRAIN = false;
    bf16_t* O; int ldc;
    __device__ __forceinline__ void operator()(const f32x4 (&acc)[2][2][4][2], const Unit& u, int wr, int wc, int fr, int fq) const {
        const int row0 = u.pm * BM + wr * 64 + fr, col0 = u.pn * HALF + wc * 32 + 8 * fq;
#pragma unroll
        for (int ai = 0; ai < 2; ++ai)
#pragma unroll
            for (int m = 0; m < 4; ++m) { bf16_t* rowp = O + (size_t)(row0 + ai * HALF + m * 16) * ldc + col0;
                const f32x4 g0 = acc[ai][0][m][0], g1 = acc[ai][0][m][1], u0 = acc[ai][1][m][0], u1 = acc[ai][1][m][1];
                u32x4 w; w.x = cvt_pk_bf16(silu_mul(g0[0], u0[0]), silu_mul(g0[1], u0[1])); w.y = cvt_pk_bf16(silu_mul(g0[2], u0[2]), silu_mul(g0[3], u0[3]));
                w.z = cvt_pk_bf16(silu_mul(g1[0], u1[0]), silu_mul(g1[1], u1[1])); w.w = cvt_pk_bf16(silu_mul(g1[2], u1[2]), silu_mul(g1[3], u1[3]));
                *(u32x4*)rowp = w; }
    }
};
template <class Epi, class Sched, bool ALIGN_EPI = false, bool SP2 = false>
__device__ __forceinline__ void gemm_phase(PG8_LAS unsigned char* lds, const Gemm g, const Sched& S, const Epi& E) {
    const int tid = threadIdx.x, wid = __builtin_amdgcn_readfirstlane(tid >> 6), lane = tid & 63, wr = wid >> 2, wc = wid & 3, fr = lane & 15, fq = lane >> 4;
    const int K = g.K, nt = K / BK;
    unsigned voffA[2], voffB[2];
#pragma unroll
    for (int i = 0; i < 2; ++i) { int R, C; stage_rc(tid * 16 + i * 8192, R, C); const int Rb = Epi::PERM ? ((R & ~31) + perm32(R & 31)) : R;
        voffA[i] = (unsigned)(R * K + C) * 2u; voffB[i] = (unsigned)(Rb * K + C) * 2u; }
    const size_t kstep = (size_t)(BK * 2);
    const size_t hstep = (size_t)HALF * K * 2;
    const size_t tstep = 2 * hstep;
    const unsigned ldsw = (unsigned)wid * 1024u;
    const int aoff = lds_byte(wr * 64 + fr, fq * 8), boff = lds_byte(wc * 32 + fr, fq * 8);
#define PG8_SA(b, h) (((b) * 2 + (h)) * HTB)
#define PG8_SB(b, h) ((4 + (b) * 2 + (h)) * HTB)
#define PG8_STAGE(bufoff, gbase, voff) do { _Pragma("unroll") for (int _i = 0; _i < 2; ++_i) \
        __builtin_amdgcn_global_load_lds((const unsigned*)((const char*)(gbase) + (voff)[_i]), (PG8_LAS unsigned*)(lds + (bufoff) + ldsw + _i * 8192), 16, 0, 0); } while (0)
#define PG8_LDA(dst, b, h) do { _Pragma("unroll") for (int m = 0; m < 4; ++m) _Pragma("unroll") for (int k = 0; k < 2; ++k) dst[m][k] = *(const PG8_LAS bf16x8*)(lds + PG8_SA(b, h) + aoff + m * 2048 + k * 1024); } while (0)
#define PG8_LDB(dst, b, h) do { _Pragma("unroll") for (int n = 0; n < 2; ++n) _Pragma("unroll") for (int k = 0; k < 2; ++k) dst[n][k] = *(const PG8_LAS bf16x8*)(lds + PG8_SB(b, h) + boff + n * 2048 + k * 1024); } while (0)
#define PG8_MMA(ai, bj, At, Bt) do { __builtin_amdgcn_s_setprio(1); _Pragma("unroll") for (int m = 0; m < 4; ++m) _Pragma("unroll") for (int n = 0; n < 2; ++n) _Pragma("unroll") for (int k = 0; k < 2; ++k) \
        acc[ai][bj][m][n] = __builtin_amdgcn_mfma_f32_16x16x32_bf16(Bt[n][k], At[m][k], acc[ai][bj][m][n], 0, 0, 0); __builtin_amdgcn_s_setprio(0); } while (0)
#define PG8_WAIT_V(n) asm volatile("s_waitcnt vmcnt(" #n ")" ::: "memory")
#define PG8_WAIT_L(n) asm volatile("s_waitcnt lgkmcnt(" #n ")" ::: "memory")
#define PG8_BAR __builtin_amdgcn_s_barrier()
#define PG8_SCHED __builtin_amdgcn_sched_barrier(0)
    Unit cur, nxt; int ui = 0;
    if (!S.next(0, cur)) return;
    f32x4 acc[2][2][4][2];
#pragma unroll
    for (int a = 0; a < 2; ++a)
#pragma unroll
        for (int b = 0; b < 2; ++b)
#pragma unroll
            for (int m = 0; m < 4; ++m)
#pragma unroll
                for (int n = 0; n < 2; ++n) acc[a][b][m][n] = (f32x4){0.f, 0.f, 0.f, 0.f};
    bf16x8 At[4][2], B0[2][2], B1[2][2];
    const char* cA = (const char*)g.A + (size_t)cur.pm * tstep; const char* cB = (const char*)g.Bt + (size_t)cur.pn * tstep;
    S.a_ready(cur);
    if constexpr (SP2) {
        PG8_STAGE(PG8_SB(0, 0), cB, voffB); PG8_STAGE(PG8_SB(0, 1), cB + hstep, voffB); PG8_STAGE(PG8_SA(0, 0), cA, voffA); PG8_STAGE(PG8_SA(0, 1), cA + hstep, voffA);
        if (wr == 1) PG8_BAR;
        PG8_WAIT_V(2); PG8_BAR;
        PG8_STAGE(PG8_SB(1, 0), cB + kstep, voffB); PG8_STAGE(PG8_SA(1, 0), cA + kstep, voffA); PG8_STAGE(PG8_SB(1, 1), cB + hstep + kstep, voffB);
        PG8_WAIT_V(6); PG8_BAR;
    } else {
        PG8_STAGE(PG8_SB(0, 0), cB, voffB); PG8_STAGE(PG8_SA(0, 0), cA, voffA); PG8_STAGE(PG8_SB(0, 1), cB + hstep, voffB); PG8_STAGE(PG8_SA(0, 1), cA + hstep, voffA);
        if (wr == 1) PG8_BAR;
        PG8_WAIT_V(4); PG8_BAR;
        PG8_STAGE(PG8_SB(1, 0), cB + kstep, voffB); PG8_STAGE(PG8_SA(1, 0), cA + kstep, voffA); PG8_STAGE(PG8_SB(1, 1), cB + hstep + kstep, voffB);
        PG8_WAIT_V(6); PG8_BAR;
    }
    for (;;) {
        const bool has_next = S.next(ui + 1, nxt);
        const char* nA = has_next ? (const char*)g.A + (size_t)nxt.pm * tstep : cA; const char* nB = has_next ? (const char*)g.Bt + (size_t)nxt.pn * tstep : cB;
        for (int t = 0; t < nt; t += 2) {
            const bool last = (t == nt - 2);
            const char* a1 = cA + (size_t)(t + 1) * kstep;
            const char* a2 = last ? nA : cA + (size_t)(t + 2) * kstep; const char* b2 = last ? nB : cB + (size_t)(t + 2) * kstep;
            const char* a3 = a2 + kstep; const char* b3 = b2 + kstep;
            if (last && has_next) S.a_ready(nxt);
            if constexpr (SP2) {
            PG8_LDB(B0, 0, 0); PG8_LDB(B1, 0, 1); PG8_SCHED; PG8_LDA(At, 0, 0); PG8_STAGE(PG8_SA(1, 1), a1 + hstep, voffA);
            PG8_WAIT_V(8); PG8_WAIT_L(0); PG8_BAR; PG8_MMA(0, 0, At, B0); PG8_MMA(0, 1, At, B1); PG8_BAR; PG8_SCHED;
            PG8_LDA(At, 0, 1); PG8_STAGE(PG8_SB(0, 0), b2, voffB); PG8_STAGE(PG8_SB(0, 1), b2 + hstep, voffB); PG8_STAGE(PG8_SA(0, 0), a2, voffA);
            PG8_WAIT_V(8); PG8_WAIT_L(0); PG8_BAR; PG8_MMA(1, 0, At, B0); PG8_MMA(1, 1, At, B1); PG8_BAR; PG8_SCHED;
            PG8_LDB(B0, 1, 0); PG8_LDB(B1, 1, 1); PG8_SCHED; PG8_LDA(At, 1, 0); PG8_STAGE(PG8_SA(0, 1), a2 + hstep, voffA);
            PG8_WAIT_V(8); PG8_WAIT_L(0); PG8_BAR; PG8_MMA(0, 0, At, B0); PG8_MMA(0, 1, At, B1); PG8_BAR; PG8_SCHED;
            PG8_LDA(At, 1, 1); PG8_STAGE(PG8_SB(1, 0), b3, voffB); PG8_STAGE(PG8_SB(1, 1), b3 + hstep, voffB); PG8_STAGE(PG8_SA(1, 0), a3, voffA);
            PG8_WAIT_V(8); PG8_WAIT_L(0); PG8_BAR; PG8_MMA(1, 0, At, B0); PG8_MMA(1, 1, At, B1); PG8_BAR; PG8_SCHED;
            } else {
            PG8_LDB(B0, 0, 0); PG8_SCHED; PG8_LDA(At, 0, 0); PG8_STAGE(PG8_SA(1, 1), a1 + hstep, voffA);
            PG8_WAIT_L(8); PG8_BAR; PG8_WAIT_L(0); PG8_MMA(0, 0, At, B0); PG8_BAR; PG8_SCHED;
            PG8_LDB(B1, 0, 1); PG8_STAGE(PG8_SB(0, 0), b2, voffB);
            PG8_BAR; PG8_WAIT_L(0); PG8_MMA(0, 1, At, B1); PG8_BAR;
            PG8_LDA(At, 0, 1); PG8_STAGE(PG8_SA(0, 0), a2, voffA);
            PG8_BAR; PG8_WAIT_L(0); PG8_MMA(1, 0, At, B0); PG8_BAR; PG8_SCHED;
            PG8_STAGE(PG8_SB(0, 1), b2 + hstep, voffB);
            PG8_WAIT_V(6); PG8_BAR; PG8_MMA(1, 1, At, B1); PG8_BAR;
            PG8_LDB(B0, 1, 0); PG8_SCHED; PG8_LDA(At, 1, 0); PG8_STAGE(PG8_SA(0, 1), a2 + hstep, voffA);
            PG8_WAIT_L(8); PG8_BAR; PG8_WAIT_L(0); PG8_MMA(0, 0, At, B0); PG8_BAR; PG8_SCHED;
            PG8_LDB(B1, 1, 1); PG8_STAGE(PG8_SB(1, 0), b3, voffB);
            PG8_BAR; PG8_WAIT_L(0); PG8_MMA(0, 1, At, B1); PG8_BAR;
            PG8_LDA(At, 1, 1); PG8_STAGE(PG8_SA(1, 0), a3, voffA);
            PG8_BAR; PG8_WAIT_L(0); PG8_MMA(1, 0, At, B0); PG8_BAR; PG8_SCHED;
            PG8_STAGE(PG8_SB(1, 1), b3 + hstep, voffB);
            PG8_WAIT_V(6); PG8_BAR; PG8_MMA(1, 1, At, B1); PG8_BAR;
            }
        }
        if constexpr (ALIGN_EPI) { if (wr == 0) PG8_BAR; }
        if constexpr (!Epi::AFTER_DRAIN) { E(acc, cur, wr, wc, fr, fq); S.done(cur); }
        if (!has_next) break;
#pragma unroll
        for (int a = 0; a < 2; ++a)
#pragma unroll
            for (int b = 0; b < 2; ++b)
#pragma unroll
                for (int m = 0; m < 4; ++m)
#pragma unroll
                    for (int n = 0; n < 2; ++n) acc[a][b][m][n] = (f32x4){0.f, 0.f, 0.f, 0.f};
        cur = nxt; cA = nA; cB = nB; ++ui;
        if constexpr (ALIGN_EPI) { if (wr == 1) PG8_BAR; }
    }
    PG8_WAIT_V(0);
    if constexpr (!ALIGN_EPI) { if (wr == 0) PG8_BAR; }
    PG8_BAR;
    if constexpr (Epi::AFTER_DRAIN) { E.fused(acc, cur, wr, wc, fr, fq, lds, wid, lane); S.done(cur); }
#undef PG8_SA
#undef PG8_SB
#undef PG8_STAGE
#undef PG8_LDA
#undef PG8_LDB
#undef PG8_MMA
#undef PG8_WAIT_V
#undef PG8_WAIT_L
#undef PG8_BAR
#undef PG8_SCHED
}
}
#define GAS __attribute__((address_space(1)))
#define LAS __attribute__((address_space(3)))
typedef unsigned short bf16;
typedef unsigned v4u __attribute__((ext_vector_type(4)));
typedef float f32x4 __attribute__((ext_vector_type(4)));
typedef short bf16x8 __attribute__((ext_vector_type(8)));
typedef GAS unsigned gu32;
typedef GAS unsigned long long gu64;
#define RLX_AGENT __ATOMIC_RELAXED, __HIP_MEMORY_SCOPE_AGENT
#define LDS_WAIT() asm volatile("s_waitcnt lgkmcnt(0)" ::: "memory")
#define VM_WAIT() asm volatile("s_waitcnt vmcnt(0)" ::: "memory")
__device__ __forceinline__ unsigned long long rt() { return __builtin_amdgcn_s_memrealtime(); }
__device__ __forceinline__ unsigned f2bf(float f) { unsigned u = __builtin_bit_cast(unsigned, f); return (u + 0x7fffu + ((u >> 16) & 1u)) >> 16; }
__device__ __forceinline__ unsigned pk2(float lo, float hi) { return f2bf(lo) | (f2bf(hi) << 16); }

#define XB_TMO      128
#define XB_XCNT(j)  (256  + 64 * (j))
#define XB_XSUB(j)  (1280 + 64 * (j))
#define XB_XGEN(j)  (2304 + 64 * (j))
#define XB_TOP      3328
#define XB_TOPGEN   3392
#define XCD_BAR_WORDS 3456
#define XB_SPIN_CAP (1u << 18)

__device__ __forceinline__ unsigned xb_ld(unsigned* p)              { return __hip_atomic_load(p, __ATOMIC_RELAXED, __HIP_MEMORY_SCOPE_AGENT); }
__device__ __forceinline__ unsigned xb_add(unsigned* p, unsigned v) { return __hip_atomic_fetch_add(p, v, __ATOMIC_RELAXED, __HIP_MEMORY_SCOPE_AGENT); }
__device__ __forceinline__ unsigned xb_xcc_id() { return (unsigned)__builtin_amdgcn_s_getreg((3 << 11) | 20) & 0xFu; }
#define XB_SPIN(cond, bar) do { unsigned _sp = 0; while (cond) { __builtin_amdgcn_s_sleep(1); \
    if ((++_sp & 255u) == 0u) { if (xb_ld(&(bar)[XB_TMO])) break; if (_sp > XB_SPIN_CAP) { atomicAdd(&(bar)[XB_TMO], 1u); break; } } } } while (0)

struct XcdBarrier {
    unsigned* bar; unsigned x;
    volatile LAS unsigned* st;
};

__device__ __forceinline__ XcdBarrier xcd_barrier_post(unsigned* bar, volatile LAS unsigned* st) {
    XcdBarrier b; b.bar = bar; b.x = xb_xcc_id(); b.st = st;
    if (threadIdx.x == 0) (void)xb_add(&bar[XB_XCNT(b.x)], 1u);
    return b;
}
__device__ __forceinline__ void xcd_barrier_complete(unsigned* bar, unsigned x, unsigned& nloc, unsigned& nx) {
    const unsigned G = gridDim.x * gridDim.y * gridDim.z;
    unsigned sum, cnt, mine, sp = 0u;
    for (;;) {
        sum = 0u; cnt = 0u; mine = 0u;
#pragma unroll
        for (unsigned j = 0; j < 16; ++j) { const unsigned c = xb_ld(&bar[XB_XCNT(j)]); sum += c; cnt += (c > 0u) ? 1u : 0u; mine = (j == x) ? c : mine; }
        if (sum == G) break;
        __builtin_amdgcn_s_sleep(1);
        if ((++sp & 255u) == 0u) { if (xb_ld(&bar[XB_TMO])) break; if (sp > XB_SPIN_CAP) { atomicAdd(&bar[XB_TMO], 1u); break; } }
    }
    nloc = mine > 0u ? mine : 1u; nx = cnt > 0u ? cnt : 1u;
}

__device__ __forceinline__ void xcd_barrier(const XcdBarrier& b) {
    asm volatile("s_waitcnt vmcnt(0)" ::: "memory");
    __syncthreads();
    if (threadIdx.x == 0) {
        unsigned* bar = b.bar;
        __builtin_amdgcn_s_waitcnt(0);
        unsigned nloc = b.st[0], nx = b.st[1];
        if (nloc == 0u) { xcd_barrier_complete(bar, b.x, nloc, nx); b.st[0] = nloc; b.st[1] = nx; }
        const unsigned old = xb_add(&bar[XB_XSUB(b.x)], 1u);
        const unsigned gen = old / nloc;
        if (old + 1u == (gen + 1u) * nloc) {
            __builtin_amdgcn_fence(__ATOMIC_RELEASE, "agent");
            asm volatile("s_waitcnt vmcnt(0)" ::: "memory");
            const unsigned og = xb_add(&bar[XB_TOP], 1u);
            const unsigned tg = og / nx;
            if (og + 1u == (tg + 1u) * nx) xb_add(&bar[XB_TOPGEN], 1u);
            else XB_SPIN(xb_ld(&bar[XB_TOPGEN]) == tg, bar);
            __builtin_amdgcn_fence(__ATOMIC_ACQUIRE, "agent");
            xb_add(&bar[XB_XGEN(b.x)], 1u);
            asm volatile("s_waitcnt vmcnt(0)" ::: "memory");
        } else {
            XB_SPIN(xb_ld(&bar[XB_XGEN(b.x)]) == gen, bar);
            __builtin_amdgcn_fence(__ATOMIC_ACQUIRE, "agent");
            asm volatile("s_waitcnt vmcnt(0)" ::: "memory");
        }
    }
    __syncthreads();
}

constexpr int NWAVES = 8;
constexpr int M = 16384, SEQ = 4096, D = 1024, DFF = 2816, NGU = 5632, NIN = 3072, NQKV = 1536, NH = 16, NKV = 4, HD = 64, WIN = 128;
constexpr float EPS = 1e-6f;
constexpr size_t MiB = 1u << 20;
constexpr size_t WS_CTL = 0, CTL_ZERO_BYTES = 64 * 1024, WS_ROPE = 1 * MiB;
constexpr size_t WS_WIN = 2 * MiB, WS_WOUT = 8 * MiB, WS_WGU0 = 10 * MiB, WS_WGU1 = 21 * MiB, WS_WDN0 = 32 * MiB, WS_WDN1 = WS_WDN0 + 5632 * 1024, WS_WQKV = 43 * MiB, WS_WO = 46 * MiB;
constexpr size_t WS_XN = 48 * MiB, WS_BIG = 80 * MiB, WS_F32 = 176 * MiB, WS_END = 240 * MiB;
constexpr int CW_BAR = 4096;
static_assert((CW_BAR + XCD_BAR_WORDS) * 4 <= (int)CTL_ZERO_BYTES, "control words inside the memset region");
constexpr int RING_OFF = 0, RING_BYTES = 131072, LDSCTL_OFF = 135168, MISC_OFF = LDSCTL_OFF + 320, LDS_BYTES = 147456;

__device__ __forceinline__ float bf_lo(unsigned w) { return __builtin_bit_cast(float, w << 16); }
__device__ __forceinline__ float bf_hi(unsigned w) { return __builtin_bit_cast(float, w & 0xffff0000u); }
__device__ __forceinline__ float wave_sum(float v) {
#pragma unroll
    for (int o = 1; o < 64; o <<= 1) v += __shfl_xor(v, o);
    return v;
}

__device__ __forceinline__ int dst_row(int mode, int row_off, int n) {
    if (mode == 0) return row_off + n;
    const int half = n >= DFF ? 1 : 0, f = n - half * DFF; return 256 * (f >> 7) + 128 * half + (f & 127);
}
__device__ __forceinline__ void cvt_item(const float* W, const float* gain, bf16* dst, int K, int N, int mode, int row_off, LAS float* scr, int item, int lane) {
    const int nblk = N / 32, kb = item / nblk, nb = item % nblk, k0 = 64 * kb, n0 = 32 * nb;
#pragma unroll 8
    for (int i = 0; i < 32; ++i) { const int kk = 2 * i + (lane >> 5); float w = W[(size_t)(k0 + kk) * N + n0 + (lane & 31)]; if (gain) w *= gain[k0 + kk]; scr[kk * 33 + (lane & 31)] = w; }
    LDS_WAIT(); asm volatile("" ::: "memory");
    const int c = lane & 7; const int r0 = dst_row(mode, row_off, n0);
#pragma unroll
    for (int j = 0; j < 4; ++j) { const int n = (lane >> 3) + 8 * j; const LAS float* s = scr + (8 * c) * 33 + n;
        v4u o; o.x = pk2(s[0 * 33], s[1 * 33]); o.y = pk2(s[2 * 33], s[3 * 33]); o.z = pk2(s[4 * 33], s[5 * 33]); o.w = pk2(s[6 * 33], s[7 * 33]);
        *(v4u*)(dst + (size_t)(r0 + n) * K + k0 + 8 * c) = o; }
    LDS_WAIT(); asm volatile("" ::: "memory");
}
__device__ __forceinline__ void sincos_d(double a, float& s_out, float& c_out) {
    const double k = __builtin_rint(a * 0.63661977236758134308);
    double r = __builtin_fma(-k, 1.57079632679489655800e+00, a); r = __builtin_fma(-k, 6.12323399573676603587e-17, r);
    const double z = r * r;
    const double s = r + r * z * (-1.66666666666666324348e-01 + z * (8.33333333332248946124e-03 + z * (-1.98412698298579493134e-04 + z * (2.75573137070700676789e-06 + z * (-2.50507602534068634195e-08 + z * 1.58969099521155010221e-10)))));
    const double c = 1.0 - 0.5 * z + z * z * (4.16666666666666019037e-02 + z * (-1.38888888888741095749e-03 + z * (2.48015872894767294178e-05 + z * (-2.75573143513906633035e-07 + z * (2.08757232129817482790e-09 + z * -1.13596475577881948265e-11)))));
    const int q = ((int)k) & 3;
    const double ss = (q == 0) ? s : (q == 1) ? c : (q == 2) ? -s : -c;
    const double cc = (q == 0) ? c : (q == 1) ? -s : (q == 2) ? -c : s;
    s_out = (float)ss; c_out = (float)cc;
}
__device__ __forceinline__ double inv_freq(int i) {
    return i == 0 ? 1.0 : i == 1 ? 1.93922744748685760285e-01 : i == 2 ? 3.76060309308639331705e-02 : i == 3 ? 7.29266473721710932476e-03 : i == 4 ? 1.41421356237309502578e-03
         : i == 5 ? 2.74248175676207299207e-04 : i == 6 ? 5.31829589694498831745e-05 : 1.03133853772124595919e-05;
}
__device__ __forceinline__ void rmsnorm_row(const float* xrow, bf16* orow, int lane) {
    const f32x4* xr = (const f32x4*)xrow + lane;
    f32x4 v[4]; float s = 0.f;
#pragma unroll
    for (int j = 0; j < 4; ++j) { v[j] = xr[64 * j]; s += (v[j].x * v[j].x + v[j].y * v[j].y) + (v[j].z * v[j].z + v[j].w * v[j].w); }
    const float r = 1.0f / sqrtf(wave_sum(s) * (1.f / D) + EPS);
    unsigned long long* o8 = (unsigned long long*)orow + lane;
#pragma unroll
    for (int j = 0; j < 4; ++j) o8[64 * j] = (unsigned long long)pk2(v[j].x * r, v[j].y * r) | ((unsigned long long)pk2(v[j].z * r, v[j].w * r) << 32);
}
__device__ __forceinline__ void resnorm_row(const float* yrow, const float* brow, const float* gain, float* orow_f, bf16* xnrow, bool bad, int lane) {
    const f32x4* yr = (const f32x4*)yrow + lane; const f32x4* br = (const f32x4*)brow + lane; const f32x4* gr = (const f32x4*)gain + lane;
    f32x4 v[4]; float s = 0.f;
#pragma unroll
    for (int j = 0; j < 4; ++j) { v[j] = yr[64 * j]; s += (v[j].x * v[j].x + v[j].y * v[j].y) + (v[j].z * v[j].z + v[j].w * v[j].w); }
    const float r = 1.0f / sqrtf(wave_sum(s) * (1.f / D) + EPS);
    float s2 = 0.f;
#pragma unroll
    for (int j = 0; j < 4; ++j) { v[j] = br[64 * j] + (v[j] * r) * gr[64 * j]; s2 += (v[j].x * v[j].x + v[j].y * v[j].y) + (v[j].z * v[j].z + v[j].w * v[j].w); }
    f32x4* orow = (f32x4*)orow_f + lane; const float qn = __builtin_nanf("");
#pragma unroll
    for (int j = 0; j < 4; ++j) orow[64 * j] = bad ? (f32x4){qn, qn, qn, qn} : v[j];
    if (xnrow) {
        const float r2 = 1.0f / sqrtf(wave_sum(s2) * (1.f / D) + EPS);
        unsigned long long* o8 = (unsigned long long*)xnrow + lane;
#pragma unroll
        for (int j = 0; j < 4; ++j) o8[64 * j] = (unsigned long long)pk2(v[j].x * r2, v[j].y * r2) | ((unsigned long long)pk2(v[j].z * r2, v[j].w * r2) << 32);
    }
}
__device__ __forceinline__ void unpack8(const v4u w, float* f) { f[0] = bf_lo(w.x); f[1] = bf_hi(w.x); f[2] = bf_lo(w.y); f[3] = bf_hi(w.y); f[4] = bf_lo(w.z); f[5] = bf_hi(w.z); f[6] = bf_lo(w.w); f[7] = bf_hi(w.w); }
__device__ __forceinline__ void conv_chunk(const bf16* bcx, const float* cw, bf16* y, int chunk, int t128) {
    const int d0 = t128 * 8, r0 = chunk * 16, pos0 = r0 & (SEQ - 1);
    float w0[8], w1[8], w2[8], p1[8], p2[8];
#pragma unroll
    for (int i = 0; i < 8; ++i) { w0[i] = cw[d0 + i]; w1[i] = cw[D + d0 + i]; w2[i] = cw[2 * D + d0 + i]; p1[i] = 0.f; p2[i] = 0.f; }
    if (pos0 != 0) {
        float c8[8], u8[8];
        { const bf16* rp = bcx + (size_t)(r0 - 2) * NIN; unpack8(*(const v4u*)(rp + D + d0), c8); unpack8(*(const v4u*)(rp + 2 * D + d0), u8);
#pragma unroll
          for (int i = 0; i < 8; ++i) p2[i] = c8[i] * u8[i]; }
        { const bf16* rp = bcx + (size_t)(r0 - 1) * NIN; unpack8(*(const v4u*)(rp + D + d0), c8); unpack8(*(const v4u*)(rp + 2 * D + d0), u8);
#pragma unroll
          for (int i = 0; i < 8; ++i) p1[i] = c8[i] * u8[i]; }
    }
    for (int t = 0; t < 16; ++t) {
        const bf16* rp = bcx + (size_t)(r0 + t) * NIN; float b8[8], c8[8], u8[8], yv[8];
        unpack8(*(const v4u*)(rp + d0), b8); unpack8(*(const v4u*)(rp + D + d0), c8); unpack8(*(const v4u*)(rp + 2 * D + d0), u8);
#pragma unroll
        for (int i = 0; i < 8; ++i) { const float cu = c8[i] * u8[i]; yv[i] = b8[i] * (w0[i] * p2[i] + w1[i] * p1[i] + w2[i] * cu); p2[i] = p1[i]; p1[i] = cu; }
        v4u o; o.x = pk2(yv[0], yv[1]); o.y = pk2(yv[2], yv[3]); o.z = pk2(yv[4], yv[5]); o.w = pk2(yv[6], yv[7]);
        *(v4u*)(y + (size_t)(r0 + t) * D + d0) = o;
    }
}
namespace att {
typedef float f32x16 __attribute__((ext_vector_type(16)));
typedef short s16x4 __attribute__((ext_vector_type(4)));
typedef short v4i16_t __attribute__((ext_vector_type(4)));
constexpr int QPITCH = 1536;
constexpr int KPL = 3088, KBUF = 8 * KPL, VBUF = 24576;
constexpr int OFF_K = 0, OFF_V = 2 * KBUF, OFF_WS = OFF_V + 2 * VBUF, OFF_OST = OFF_WS + 8 * 256, ATT_LDS = OFF_OST + 8 * 4096;
constexpr float C2 = 0.125f * 1.4426950408889634f;
__device__ __forceinline__ int crow(int r, int hi) { return (r & 3) + 8 * (r >> 2) + 4 * hi; }
__device__ __forceinline__ unsigned cvtpk(float lo, float hi) { typedef float f2 __attribute__((ext_vector_type(2))); typedef __bf16 b2 __attribute__((ext_vector_type(2))); f2 v = {lo, hi}; b2 b = __builtin_convertvector(v, b2); return __builtin_bit_cast(unsigned, b); }
struct KVRegs { v4u k[3], v[3]; };
__device__ __forceinline__ void load_kv(KVRegs& R, const bf16* qkv, size_t rowb, int t0, int g, int tid) {
#pragma unroll
    for (int i = 0; i < 3; ++i) { const int e = tid + 512 * i, key = e >> 3, c = e & 7, j = t0 - 128 + key;
        v4u kk = (v4u){0u, 0u, 0u, 0u}, vv = kk;
        if (j >= 0) { const bf16* rp = qkv + (rowb + j) * QPITCH + g * 64 + c * 8; kk = *(const v4u*)(rp + 1024); vv = *(const v4u*)(rp + 1280); }
        R.k[i] = kk; R.v[i] = vv; }
}
__device__ __forceinline__ void write_kv(const KVRegs& R, LAS unsigned char* lds, int buf, int tid) {
#pragma unroll
    for (int i = 0; i < 3; ++i) { const int e = tid + 512 * i, key = e >> 3, c = e & 7;
        *(LAS v4u*)(lds + OFF_K + buf * KBUF + c * KPL + key * 16) = R.k[i];
        *(LAS v4u*)(lds + OFF_V + buf * VBUF + ((c >> 2) * 12 + (key >> 4)) * 1024 + (key & 15) * 64 + (c & 3) * 16) = R.v[i]; }
}
__device__ __forceinline__ void attn_compute(const bf16* qkv, const float* sinks, bf16* out, LAS unsigned char* lds, int buf, size_t rowb, int t0, int g, int wave, int lane) {
    const int r32 = lane & 31, hi = lane >> 5, hq = wave & 3, sb = wave >> 2, h = 4 * g + hq, tq = t0 + 32 * sb;
    bf16x8 qr[4];
    { const bf16* qp = qkv + (rowb + tq + r32) * QPITCH + h * 64 + hi * 8;
#pragma unroll
      for (int d0 = 0; d0 < 4; ++d0) qr[d0] = *(const bf16x8*)(qp + d0 * 16); }
    f32x16 S[5];
    const LAS unsigned char* kb = lds + OFF_K + buf * KBUF + hi * KPL + (sb * 32 + r32) * 16;
#pragma unroll
    for (int i = 0; i < 5; ++i) {
        f32x16 acc = {};
#pragma unroll
        for (int d0 = 0; d0 < 4; ++d0) { const bf16x8 kf = *(const LAS bf16x8*)(kb + d0 * 2 * KPL + i * 512); acc = __builtin_amdgcn_mfma_f32_32x32x16_bf16(kf, qr[d0], acc, 0, 0, 0); }
        S[i] = acc;
    }
    const float NEG = -INFINITY;
#pragma unroll
    for (int i = 0; i < 5; ++i) {
        const bool tile_ok = (tq + 32 * i) >= 128;
#pragma unroll
        for (int r = 0; r < 16; ++r) { const int kk = crow(r, hi); bool ok = tile_ok; if (i == 0) ok = ok && (kk > r32); if (i == 4) ok = ok && (kk <= r32); S[i][r] = ok ? S[i][r] * C2 : NEG; }
    }
    const float sink2 = sinks[h] * 1.4426950408889634f;
    float mx = sink2;
#pragma unroll
    for (int i = 0; i < 5; ++i)
#pragma unroll
        for (int r = 0; r < 16; ++r) mx = fmaxf(mx, S[i][r]);
    { auto rr = __builtin_amdgcn_permlane32_swap(__float_as_uint(mx), __float_as_uint(mx), false, false); mx = fmaxf(__uint_as_float(rr[0]), __uint_as_float(rr[1])); }
    float lsum = 0.f;
#pragma unroll
    for (int i = 0; i < 5; ++i)
#pragma unroll
        for (int r = 0; r < 16; ++r) { const float p = __builtin_amdgcn_exp2f(S[i][r] - mx); S[i][r] = p; lsum += p; }
    { auto rr = __builtin_amdgcn_permlane32_swap(__float_as_uint(lsum), __float_as_uint(lsum), false, false); lsum = __uint_as_float(rr[0]) + __uint_as_float(rr[1]); }
    lsum += __builtin_amdgcn_exp2f(sink2 - mx);
    LAS float* wsf = (LAS float*)(lds + OFF_WS + wave * 256);
    if (hi == 0) wsf[r32] = 1.0f / lsum;
    f32x16 o[2]; o[0] = f32x16{}; o[1] = f32x16{};
    const LAS unsigned char* vb = lds + OFF_V + buf * VBUF + (4 * hi + ((lane & 15) >> 2)) * 64 + ((lane >> 4) & 1) * 32 + (lane & 3) * 8;
#pragma unroll
    for (int i = 0; i < 5; ++i)
#pragma unroll
        for (int s = 0; s < 2; ++s) {
            v4u pw; pw.x = cvtpk(S[i][8 * s], S[i][8 * s + 1]); pw.y = cvtpk(S[i][8 * s + 2], S[i][8 * s + 3]); pw.z = cvtpk(S[i][8 * s + 4], S[i][8 * s + 5]); pw.w = cvtpk(S[i][8 * s + 6], S[i][8 * s + 7]);
            const bf16x8 pa = __builtin_bit_cast(bf16x8, pw);
#pragma unroll
            for (int dh = 0; dh < 2; ++dh) {
                const LAS unsigned char* vp = vb + (dh * 12 + (sb + i) * 2 + s) * 1024;
                const s16x4 lo = __builtin_bit_cast(s16x4, __builtin_amdgcn_ds_read_tr16_b64_v4i16((LAS v4i16_t*)vp));
                const s16x4 hh = __builtin_bit_cast(s16x4, __builtin_amdgcn_ds_read_tr16_b64_v4i16((LAS v4i16_t*)(vp + 512)));
                const bf16x8 vf = (bf16x8){lo[0], lo[1], lo[2], lo[3], hh[0], hh[1], hh[2], hh[3]};
                o[dh] = __builtin_amdgcn_mfma_f32_32x32x16_bf16(pa, vf, o[dh], 0, 0, 0);
            }
        }
    LAS bf16* stg = (LAS bf16*)(lds + OFF_OST + wave * 4096);
#pragma unroll
    for (int r = 0; r < 16; ++r) { const int q = crow(r, hi); const float il = wsf[q];
#pragma unroll
        for (int dh = 0; dh < 2; ++dh) stg[q * 64 + dh * 32 + r32] = (bf16)f2bf(o[dh][r] * il); }
    bf16* ow = out + (rowb + tq) * 1024 + h * 64;
#pragma unroll
    for (int i = 0; i < 4; ++i) { const int row = i * 8 + (lane >> 3), ch = lane & 7; const v4u v = *(const LAS v4u*)(stg + row * 64 + ch * 8); *(v4u*)(ow + (size_t)row * 1024 + ch * 8) = v; }
}
__device__ __forceinline__ void attn_phase(const bf16* qkv, const float* sinks, bf16* out, LAS unsigned char* lds, int bx, int G, int tid, int wave, int lane) {
    KVRegs R; int it = bx; int buf = 0;
    if (it < 1024) { load_kv(R, qkv, (size_t)(it >> 8) * SEQ, 64 * (it & 63), (it >> 6) & 3, tid); write_kv(R, lds, 0, tid); }
    __syncthreads();
    for (; it < 1024; it += G) {
        const int nx = it + G; const bool has_next = nx < 1024;
        if (has_next) load_kv(R, qkv, (size_t)(nx >> 8) * SEQ, 64 * (nx & 63), (nx >> 6) & 3, tid);
        attn_compute(qkv, sinks, out, lds, buf, (size_t)(it >> 8) * SEQ, 64 * (it & 63), (it >> 6) & 3, wave, lane);
        if (has_next) write_kv(R, lds, buf ^ 1, tid);
        __syncthreads();
        buf ^= 1;
    }
}
}
struct Args { const float* in[17]; float* out; unsigned char* ws; };
__global__ void __launch_bounds__(NWAVES * 64, 2) fwd(Args args) {
    extern __shared__ __attribute__((aligned(16))) unsigned char lds_raw[];
    LAS unsigned char* lds = (LAS unsigned char*)lds_raw;
    volatile LAS unsigned* MISC = (volatile LAS unsigned*)(lds + MISC_OFF);
    const int tid = threadIdx.x, lane = tid & 63, wave = __builtin_amdgcn_readfirstlane(tid >> 6);
    const int G = gridDim.x, bx = blockIdx.x; const int vcu = (G % 8 == 0) ? (bx % 8) * (G / 8) + bx / 8 : bx;
    unsigned char* ws = args.ws; gu32* ctl = (gu32*)(ws + WS_CTL);
    const float* x = args.in[0]; const float* a_pre = args.in[1]; const float* a_win = args.in[2]; const float* a_cw = args.in[3];
    const float* a_wout = args.in[4]; const float* a_post = args.in[5]; const float* f_pre = args.in[6]; const float* f_wgu = args.in[7];
    const float* f_wdn = args.in[8]; const float* f_post = args.in[9]; const float* kv_norm = args.in[10]; const float* w_kv = args.in[11];
    const float* b_pre = args.in[12]; const float* b_wq = args.in[13]; const float* b_sinks = args.in[14]; const float* b_wo = args.in[15]; const float* b_post = args.in[16];
    float* out = args.out;
    bf16 *Win = (bf16*)(ws + WS_WIN), *Wout = (bf16*)(ws + WS_WOUT), *Wgu0 = (bf16*)(ws + WS_WGU0), *Wgu1 = (bf16*)(ws + WS_WGU1), *Wdn0 = (bf16*)(ws + WS_WDN0), *Wdn1 = (bf16*)(ws + WS_WDN1), *Wqkv = (bf16*)(ws + WS_WQKV), *Wo = (bf16*)(ws + WS_WO);
    bf16 *XN = (bf16*)(ws + WS_XN), *BIG = (bf16*)(ws + WS_BIG); float* F32 = (float*)(ws + WS_F32); float* cs = (float*)(ws + WS_ROPE);
    bf16* ATT = (bf16*)(ws + WS_BIG + 48 * MiB);
    for (int u = tid; u < (LDS_BYTES - LDSCTL_OFF) / 4; u += NWAVES * 64) ((LAS unsigned*)(lds + LDSCTL_OFF))[u] = 0u;
    __syncthreads();
    XcdBarrier bar = xcd_barrier_post((unsigned*)(ctl + CW_BAR), MISC + 8);
    const int gw = vcu * NWAVES + wave, NGW = G * NWAVES;
#define GRID_BAR() xcd_barrier(bar)
#define GEMM_PHASE(EPI, A_, B_, N_, K_, ...) do { pg8::Gemm g{A_, B_, M, N_, K_}; pg8::StaticOrder S; S.init(M, N_, G, bx); pg8::EPI E{__VA_ARGS__}; \
        pg8::gemm_phase<pg8::EPI, pg8::StaticOrder, true, true>(lds + RING_OFF, g, S, E); } while (0)
#define RESNORM_PHASE(Y_, BASE_, GAIN_, OUT_, XN_, BAD_) do { for (int m = gw; m < M; m += NGW) resnorm_row((Y_) + (size_t)m * D, (BASE_) + (size_t)m * D, GAIN_, (OUT_) + (size_t)m * D, (XN_) ? (XN_) + (size_t)m * D : nullptr, BAD_, lane); } while (0)

    {
        LAS float* scr = (LAS float*)(lds + RING_OFF + wave * 16384);
        constexpr int I_IN = (D / 64) * (NIN / 32), I_DD = (D / 64) * (D / 32), I_GU = (D / 64) * (NGU / 32), I_DN = (DFF / 64) * (D / 32), I_KV = (D / 64) * (512 / 32);
        constexpr int NITEMS = I_IN + 3 * I_DD + 2 * I_GU + 2 * I_DN + I_KV;
        for (int it = gw; it < NITEMS; it += NGW) {
            int r = it;
            if (r < I_IN) { cvt_item(a_win, a_pre, Win, D, NIN, 0, 0, scr, r, lane); continue; } r -= I_IN;
            if (r < I_DD) { cvt_item(a_wout, nullptr, Wout, D, D, 0, 0, scr, r, lane); continue; } r -= I_DD;
            if (r < I_GU) { cvt_item(f_wgu, f_pre, Wgu0, D, NGU, 1, 0, scr, r, lane); continue; } r -= I_GU;
            if (r < I_GU) { cvt_item(f_wgu + (size_t)D * NGU, f_pre + D, Wgu1, D, NGU, 1, 0, scr, r, lane); continue; } r -= I_GU;
            if (r < I_DN) { cvt_item(f_wdn, nullptr, Wdn0, DFF, D, 0, 0, scr, r, lane); continue; } r -= I_DN;
            if (r < I_DN) { cvt_item(f_wdn + (size_t)DFF * D, nullptr, Wdn1, DFF, D, 0, 0, scr, r, lane); continue; } r -= I_DN;
            if (r < I_DD) { cvt_item(b_wq, b_pre, Wqkv, D, D, 0, 0, scr, r, lane); continue; } r -= I_DD;
            if (r < I_KV) { cvt_item(w_kv, kv_norm, Wqkv, D, 512, 0, 1024, scr, r, lane); continue; } r -= I_KV;
            cvt_item(b_wo, nullptr, Wo, D, D, 0, 0, scr, r, lane);
        }
        for (int idx = vcu * 512 + tid; idx < SEQ * 8; idx += G * 512) { const int pos = idx >> 3, i = idx & 7; float s, c; sincos_d((double)pos * inv_freq(i), s, c); cs[idx] = c; cs[SEQ * 8 + idx] = s; }
        for (int m = gw; m < M; m += NGW) rmsnorm_row(x + (size_t)m * D, XN + (size_t)m * D, lane);
    }
    GRID_BAR();
    GEMM_PHASE(EpiBf16<0>, XN, Win, NIN, D, BIG, NIN, nullptr, 0, 0, 1.f);
    GRID_BAR();
    for (int ch = bx * 4 + (tid >> 7); ch < M / 16; ch += G * 4) conv_chunk(BIG, a_cw, XN, ch, tid & 127);
    GRID_BAR();
    GEMM_PHASE(EpiF32, XN, Wout, D, D, F32, D);
    GRID_BAR();
    RESNORM_PHASE(F32, x, a_post, out, XN, false);
    GRID_BAR();
    GEMM_PHASE(EpiSwiGLU, XN, Wgu0, NGU, D, BIG, DFF);
    GRID_BAR();
    GEMM_PHASE(EpiF32, BIG, Wdn0, D, DFF, F32, D);
    GRID_BAR();
    RESNORM_PHASE(F32, out, f_post, out, XN, false);
    GRID_BAR();
    GEMM_PHASE(EpiBf16<0>, XN, Wqkv, NQKV, D, BIG, NQKV, nullptr, 0, 0, 1.f);
    GRID_BAR();
    for (int idx = vcu * 512 + tid; idx < M * 160; idx += G * 512) {
        const int i = idx & 7, hs = (idx >> 3) % 20, row = idx / 160, pos = row & (SEQ - 1); const float c = cs[pos * 8 + i], s = cs[SEQ * 8 + pos * 8 + i];
        bf16* p = BIG + (size_t)row * NQKV + (hs < 16 ? hs * 64 : 1024 + (hs - 16) * 64) + i;
        const float x1 = __builtin_bit_cast(float, (unsigned)p[0] << 16), x2 = __builtin_bit_cast(float, (unsigned)p[8] << 16);
        p[0] = (bf16)f2bf(x1 * c - x2 * s); p[8] = (bf16)f2bf(x2 * c + x1 * s);
    }
    GRID_BAR();
    att::attn_phase(BIG, b_sinks, ATT, lds + RING_OFF, bx, G, tid, wave, lane);
    GRID_BAR();
    GEMM_PHASE(EpiF32, ATT, Wo, D, D, F32, D);
    GRID_BAR();
    RESNORM_PHASE(F32, out, b_post, out, XN, false);
    GRID_BAR();
    GEMM_PHASE(EpiSwiGLU, XN, Wgu1, NGU, D, BIG, DFF);
    GRID_BAR();
    GEMM_PHASE(EpiF32, BIG, Wdn1, D, DFF, F32, D);
    GRID_BAR();
    { const bool bad = __hip_atomic_load((gu32*)(ctl + CW_BAR) + XB_TMO, RLX_AGENT) != 0u;
      bf16* nobf = nullptr; RESNORM_PHASE(F32, out, f_post + D, out, nobf, bad); }
}

extern "C" void kernel_launch(void* const* d_in, const int* in_sizes, int n_in, void* d_out, int out_size, void* d_ws, size_t ws_size, hipStream_t stream) {
    static int grid = 0;
    if (grid == 0) {
        if (n_in != 17 || in_sizes[0] != M * D || out_size != M * D || ws_size < WS_END) { fprintf(stderr, "kernel_launch: unexpected shapes (n_in %d in0 %d out %d ws %zu)\n", n_in, n_in > 0 ? in_sizes[0] : -1, out_size, ws_size); grid = -1; return; }
        int dev = 0, cus = 0, per_cu = 0;
        if (hipGetDevice(&dev) != hipSuccess || hipDeviceGetAttribute(&cus, hipDeviceAttributeMultiprocessorCount, dev) != hipSuccess) { grid = -1; return; }
        if (hipFuncSetAttribute((const void*)fwd, hipFuncAttributeMaxDynamicSharedMemorySize, LDS_BYTES) != hipSuccess) { fprintf(stderr, "kernel_launch: hipFuncSetAttribute failed\n"); grid = -1; return; }
        if (hipOccupancyMaxActiveBlocksPerMultiprocessor(&per_cu, (const void*)fwd, NWAVES * 64, LDS_BYTES) != hipSuccess || per_cu < 1) { fprintf(stderr, "kernel_launch: occupancy query says %d blocks per CU\n", per_cu); }
        (void)hipGetLastError();
        grid = cus;
    }
    if (grid < 0) return;
    if (hipMemsetAsync((char*)d_ws + WS_CTL, 0, CTL_ZERO_BYTES, stream) != hipSuccess) return;
    Args a; memset(&a, 0, sizeof a);
    for (int i = 0; i < 17; ++i) a.in[i] = (const float*)d_in[i];
    a.out = (float*)d_out; a.ws = (unsigned char*)d_ws;
    hipLaunchKernelGGL(fwd, dim3(grid), dim3(NWAVES * 64), LDS_BYTES, stream, a);
}
```
